# Optimizing an MI355X kernel written in HIP

```python
import math
import jax
import jax.numpy as jnp
from jax import lax
import numpy as np

D_MODEL = 1024
BATCH = 8
SEQ = 2048
DEPTH = 1

DA_HEADS = 4
DA_HEAD_DIM = 64
DA_V_DIM = 2 * DA_HEAD_DIM
RET_HEADS = 4
RET_QK_DIM = 64
RET_V_DIM = 128
RET_CHUNK = 128
Q_BLOCK = 128
D_FF = 2816
ROPE_THETA = 10000.0
EPS = 1e-6
N_MOD = 9

DA_QK_W = DA_HEADS * 2 * DA_HEAD_DIM
DA_V_W = DA_HEADS * DA_V_DIM
RET_QK_W = RET_HEADS * RET_QK_DIM
RET_V_W = RET_HEADS * RET_V_DIM
IN_SPLITS = (DA_QK_W, DA_QK_W, DA_V_W, RET_QK_W, RET_QK_W, RET_V_W, RET_V_W, D_MODEL, D_MODEL)
IN_WIDTH = 2 * DA_QK_W + DA_V_W + 2 * RET_QK_W + 2 * RET_V_W + 2 * D_MODEL

kernel_name = 'hybrid_diffattn_retention_macaron'


def rmsnorm(x, g):
    xf = x.astype(jnp.float32)
    y = xf * lax.rsqrt(jnp.mean(xf * xf, axis=-1, keepdims=True) + EPS)
    return (y * g.astype(jnp.float32)).astype(x.dtype)


def rope_half(x, pos):
    d = x.shape[-1]
    inv = 1.0 / (ROPE_THETA ** (jnp.arange(0, d, 2, dtype=jnp.float32) / d))
    ang = pos.astype(jnp.float32)[..., None] * inv
    cos = jnp.cos(ang)[:, :, None, :]
    sin = jnp.sin(ang)[:, :, None, :]
    xf = x.astype(jnp.float32)
    x1, x2 = xf[..., : d // 2], xf[..., d // 2:]
    return jnp.concatenate([x1 * cos - x2 * sin, x2 * cos + x1 * sin], axis=-1).astype(x.dtype)


def retnet_rotate(x, pos):
    d = x.shape[-1]
    angle = 1.0 / (ROPE_THETA ** jnp.linspace(0.0, 1.0, d // 2, dtype=jnp.float32))
    ang = pos.astype(jnp.float32)[..., None] * angle
    cos = jnp.cos(ang)[:, :, None, :]
    sin = jnp.sin(ang)[:, :, None, :]
    xf = x.astype(jnp.float32)
    xe, xo = xf[..., 0::2], xf[..., 1::2]
    out = jnp.stack([xe * cos - xo * sin, xo * cos + xe * sin], axis=-1)
    return out.reshape(x.shape).astype(x.dtype)


def swiglu(h, w1, w3, w2):
    return (jax.nn.silu(h @ w1) * (h @ w3)) @ w2


def diff_attention(q, k, v, lam):
    b, nh, _, s, d = q.shape
    nq = s // Q_BLOCK
    scale = d ** -0.5
    qb = q.reshape(b, nh, 2, nq, Q_BLOCK, d).transpose(3, 0, 1, 2, 4, 5)

    def block(qblk):
        sc = jnp.einsum('bhmqd,bhmkd->bhmqk', qblk, k).astype(jnp.float32) * scale
        p = jax.nn.softmax(sc, axis=-1)
        w = p[:, :, 0] - lam * p[:, :, 1]
        return jnp.einsum('bhqk,bhkv->bhqv', w.astype(v.dtype), v)

    o = lax.map(block, qb)
    return o.transpose(1, 0, 3, 2, 4).reshape(b, s, nh, v.shape[-1])


def retention_chunkwise(q, k, v, log_gamma):
    b, nh, s, dk = q.shape
    dv = v.shape[-1]
    n = s // RET_CHUNK
    qc = q.reshape(b, nh, n, RET_CHUNK, dk)
    kc = k.reshape(b, nh, n, RET_CHUNK, dk)
    vc = v.reshape(b, nh, n, RET_CHUNK, dv)
    idx = jnp.arange(RET_CHUNK, dtype=jnp.float32)
    rel = idx[:, None] - idx[None, :]
    lower = rel >= 0
    lg = log_gamma[:, None, None]
    dmat = jnp.where(lower[None], jnp.exp(jnp.where(lower, rel, 0.0)[None] * lg), 0.0)
    scores = jnp.einsum('bhncd,bhnjd->bhncj', qc, kc) * dmat[None, :, None]
    intra = jnp.einsum('bhncj,bhnje->bhnce', scores, vc)
    zeta = jnp.exp((RET_CHUNK - 1.0 - idx)[None, :] * log_gamma[:, None])
    xi = jnp.exp((idx + 1.0)[None, :] * log_gamma[:, None])
    kv = jnp.einsum('bhnjd,bhnje->nbhde', kc * zeta[None, :, None, :, None], vc)
    chunk_decay = jnp.exp(RET_CHUNK * log_gamma)[None, :, None, None]

    def step(state, kv_n):
        return state * chunk_decay + kv_n, state

    _, r_prev = lax.scan(step, jnp.zeros((b, nh, dk, dv), jnp.float32), kv)
    cross = jnp.einsum('bhncd,nbhde->bhnce', qc * xi[None, :, None, :, None], r_prev)
    return (intra + cross).reshape(b, nh, s, dv)


def token_mixing(h, positions, w_in, b_merge, da_q_gain, da_k_gain, lq1, lk1, lq2, lk2,
                 da_subln, ret_decay_f, ret_decay_b, ret_norm, w_branch_a, w_branch_r,
                 w_out, lam_init):
    b, s, _ = h.shape
    z = h @ w_in
    split_idx = [int(i) for i in np.cumsum(IN_SPLITS)[:-1]]
    qa, ka, va, qr, kr, vr, ret_gate, merge_a, merge_r = jnp.split(z, split_idx, axis=-1)

    qa = rope_half(rmsnorm(qa.reshape(b, s, DA_HEADS * 2, DA_HEAD_DIM), da_q_gain), positions)
    ka = rope_half(rmsnorm(ka.reshape(b, s, DA_HEADS * 2, DA_HEAD_DIM), da_k_gain), positions)
    qa = qa.reshape(b, s, DA_HEADS, 2, DA_HEAD_DIM).transpose(0, 2, 3, 1, 4)
    ka = ka.reshape(b, s, DA_HEADS, 2, DA_HEAD_DIM).transpose(0, 2, 3, 1, 4)
    va = va.reshape(b, s, DA_HEADS, DA_V_DIM).transpose(0, 2, 1, 3)
    f32 = jnp.float32
    lam = (jnp.exp(jnp.sum(lq1.astype(f32) * lk1.astype(f32)))
           - jnp.exp(jnp.sum(lq2.astype(f32) * lk2.astype(f32))) + lam_init)
    oa = diff_attention(qa, ka, va, lam)
    oa = (rmsnorm(oa, da_subln) * (1.0 - lam_init)).reshape(b, s, DA_V_W)

    qr = retnet_rotate(qr.reshape(b, s, RET_HEADS, RET_QK_DIM), positions)
    kr = retnet_rotate(kr.reshape(b, s, RET_HEADS, RET_QK_DIM), positions) * (RET_QK_DIM ** -0.5)
    qr = qr.astype(f32).transpose(0, 2, 1, 3)
    kr = kr.astype(f32).transpose(0, 2, 1, 3)
    vr = vr.reshape(b, s, RET_HEADS, RET_V_DIM).astype(f32).transpose(0, 2, 1, 3)
    lg_f = jax.nn.log_sigmoid(ret_decay_f.astype(f32))
    lg_b = jax.nn.log_sigmoid(ret_decay_b.astype(f32))
    y_f = retention_chunkwise(qr, kr, vr, lg_f)
    y_b = jnp.flip(retention_chunkwise(jnp.flip(qr, 2), jnp.flip(kr, 2), jnp.flip(vr, 2), lg_b), 2)
    y = (y_f + y_b).transpose(0, 2, 1, 3).astype(h.dtype)
    y = rmsnorm(y, ret_norm).reshape(b, s, RET_V_W) * jax.nn.silu(ret_gate)

    p_a = oa @ w_branch_a
    p_r = y @ w_branch_r
    merged = (jax.nn.sigmoid(merge_a + b_merge[0]) * p_a
              + jax.nn.sigmoid(merge_r + b_merge[1]) * p_r)
    return merged @ w_out


def setup_inputs(seed: int = 0) -> dict:
    key = jax.random.key(seed)
    ks = jax.random.split(key, 32)
    f32 = jnp.float32
    L = DEPTH
    D = D_MODEL

    def nrm(k, shape, scale):
        return jax.random.normal(k, shape, f32) * scale

    def gain(k, shape):
        return 1.0 + 0.05 * jax.random.normal(k, shape, f32)

    base_logit = jnp.log(2.0 ** (5.0 + jnp.arange(RET_HEADS, dtype=f32)) - 1.0)
    offset = jax.random.randint(ks[2], (BATCH, 1), 0, 1024, dtype=jnp.int32)
    positions = jnp.arange(SEQ, dtype=jnp.int32)[None, :] + offset
    return {
        'x': nrm(ks[0], (BATCH, SEQ, D), 1.0),
        'c': nrm(ks[1], (BATCH, D), 1.0),
        'positions': positions,
        'w_ada': nrm(ks[3], (L, D, N_MOD * D), D ** -0.5),
        'b_ada': nrm(ks[4], (L, N_MOD * D), 0.02),
        'norm_ffn1': gain(ks[5], (L, D)),
        'ffn1_w1': nrm(ks[6], (L, D, D_FF), D ** -0.5),
        'ffn1_w3': nrm(ks[7], (L, D, D_FF), D ** -0.5),
        'ffn1_w2': nrm(ks[8], (L, D_FF, D), D_FF ** -0.5),
        'norm_mix': gain(ks[9], (L, D)),
        'w_in': nrm(ks[10], (L, D, IN_WIDTH), D ** -0.5),
        'b_merge': nrm(ks[11], (L, 2, D), 0.02),
        'da_q_gain': gain(ks[12], (L, DA_HEAD_DIM)),
        'da_k_gain': gain(ks[13], (L, DA_HEAD_DIM)),
        'da_lambda_q1': nrm(ks[14], (L, DA_HEAD_DIM), 0.1),
        'da_lambda_k1': nrm(ks[15], (L, DA_HEAD_DIM), 0.1),
        'da_lambda_q2': nrm(ks[16], (L, DA_HEAD_DIM), 0.1),
        'da_lambda_k2': nrm(ks[17], (L, DA_HEAD_DIM), 0.1),
        'da_subln': gain(ks[18], (L, DA_V_DIM)),
        'ret_decay_f': base_logit[None] + nrm(ks[19], (L, RET_HEADS), 0.1),
        'ret_decay_b': base_logit[None] + nrm(ks[20], (L, RET_HEADS), 0.1),
        'ret_norm': gain(ks[21], (L, RET_V_DIM)),
        'w_branch_a': nrm(ks[22], (L, DA_V_W, D), DA_V_W ** -0.5),
        'w_branch_r': nrm(ks[23], (L, RET_V_W, D), RET_V_W ** -0.5),
        'w_out': nrm(ks[24], (L, D, D), D ** -0.5),
        'norm_ffn2': gain(ks[25], (L, D)),
        'ffn2_w1': nrm(ks[26], (L, D, D_FF), D ** -0.5),
        'ffn2_w3': nrm(ks[27], (L, D, D_FF), D ** -0.5),
        'ffn2_w2': nrm(ks[28], (L, D_FF, D), D_FF ** -0.5),
    }


def reference(x, c, positions, w_ada, b_ada, norm_ffn1, ffn1_w1, ffn1_w3, ffn1_w2,
              norm_mix, w_in, b_merge, da_q_gain, da_k_gain, da_lambda_q1, da_lambda_k1,
              da_lambda_q2, da_lambda_k2, da_subln, ret_decay_f, ret_decay_b, ret_norm,
              w_branch_a, w_branch_r, w_out, norm_ffn2, ffn2_w1, ffn2_w3, ffn2_w2):
    b = x.shape[0]
    for l in range(DEPTH):
        lam_init = 0.8 - 0.6 * math.exp(-0.3 * l)
        mod = (jax.nn.silu(c) @ w_ada[l] + b_ada[l]).reshape(b, N_MOD, 1, D_MODEL)
        sh1, sc1, g1, sh2, sc2, g2, sh3, sc3, g3 = [mod[:, i] for i in range(N_MOD)]

        h = rmsnorm(x, norm_ffn1[l]) * (1.0 + sc1) + sh1
        x = x + 0.5 * g1 * swiglu(h, ffn1_w1[l], ffn1_w3[l], ffn1_w2[l])

        h = rmsnorm(x, norm_mix[l]) * (1.0 + sc2) + sh2
        x = x + g2 * token_mixing(h, positions, w_in[l], b_merge[l], da_q_gain[l], da_k_gain[l],
                                  da_lambda_q1[l], da_lambda_k1[l], da_lambda_q2[l], da_lambda_k2[l],
                                  da_subln[l], ret_decay_f[l], ret_decay_b[l], ret_norm[l],
                                  w_branch_a[l], w_branch_r[l], w_out[l], lam_init)

        h = rmsnorm(x, norm_ffn2[l]) * (1.0 + sc3) + sh3
        x = x + 0.5 * g3 * swiglu(h, ffn2_w1[l], ffn2_w3[l], ffn2_w2[l])
    return x
```

```cpp
#include <hip/hip_runtime.h>
#include <hip/hip_cooperative_groups.h>
#include <cstdio>
#include <cstdint>
#include <cmath>
namespace cg = cooperative_groups;

namespace pg8 {
#define PG8_LAS __attribute__((address_space(3)))
typedef unsigned short bf16_t;
typedef short bf16x8 __attribute__((ext_vector_type(8)));
typedef float f32x4 __attribute__((ext_vector_type(4)));
typedef unsigned u32x4 __attribute__((ext_vector_type(4)));
constexpr int BM = 256, BK = 64, HALF = 128, HTB = HALF * BK * 2  , STAGE_BYTES = 8 * HTB, NXCD = 8, WGM = 8;

__host__ __device__ __forceinline__ int lds_byte(int r, int c) { const int st = (r >> 4) * 2 + (c >> 5), rr = r & 15, cc = c & 31, ob = rr * 64 + cc * 2; return st * 1024 + (ob ^ (((ob >> 9) & 1) << 5)); }
__host__ __device__ __forceinline__ void stage_rc(int b, int& R, int& C) { const int st = b / 1024, sb = b % 1024, swz = sb ^ (((sb >> 9) & 1) << 5); R = (st >> 1) * 16 + swz / 64; C = (st & 1) * 32 + (swz % 64) / 2; }
__host__ __device__ __forceinline__ int perm32(int rho) { const int n = rho >> 4, i = rho & 15; return 8 * (i >> 2) + 4 * n + (i & 3); }

struct Unit { int pm, pn; };
struct Gemm { const bf16_t* A; const bf16_t* Bt; int M, N, K; };

struct StaticOrder {
    int nM, nN, nwg, G, c;
    __host__ __device__ void init(int M, int N, int G_, int c_) { nM = M / BM; nN = N / BM; nwg = nM * nN; G = G_; c = c_; }
    __host__ __device__ bool next(int i, Unit& u) const {
        const long L = (long)i * G + c; if (L >= nwg) return false;
        int wgid = (int)L; { const int q = nwg / NXCD, r = nwg % NXCD, xcd = wgid % NXCD, off = wgid / NXCD; wgid = (xcd < r ? xcd * (q + 1) : r * (q + 1) + (xcd - r) * q) + off; }
        const int nig = WGM * nN, gid = wgid / nig, fm = gid * WGM, gsz = (nM - fm) < WGM ? (nM - fm) : WGM;
        u.pm = fm + ((wgid % nig) % gsz); u.pn = (wgid % nig) / gsz; return true;
    }
    __device__ __forceinline__ void a_ready(const Unit&) const {}
    __device__ __forceinline__ void done(const Unit&) const {}
};

__device__ __forceinline__ unsigned cvt_pk_bf16(float lo, float hi) { unsigned r; asm volatile("v_cvt_pk_bf16_f32 %0, %1, %2" : "=v"(r) : "v"(lo), "v"(hi)); return r; }
typedef float f32x2 __attribute__((ext_vector_type(2)));
__device__ __forceinline__ float bflo(unsigned w) { return __uint_as_float(w << 16); }
__device__ __forceinline__ float bfhi(unsigned w) { return __uint_as_float(w & 0xffff0000u); }
__device__ __forceinline__ float sigm(float v) { return __builtin_amdgcn_rcpf(1.f + __builtin_amdgcn_exp2f(-1.4426950408889634f * v)); }
__device__ __forceinline__ float silu(float v) { return v * sigm(v); }
__device__ __forceinline__ u32x4 pack8(const float (&o)[8]) { u32x4 w; w.x = cvt_pk_bf16(o[0], o[1]); w.y = cvt_pk_bf16(o[2], o[3]); w.z = cvt_pk_bf16(o[4], o[5]); w.w = cvt_pk_bf16(o[6], o[7]); return w; }

struct EpiUp {
    static constexpr bool PERM = true, AFTER_DRAIN = false;
    bf16_t* U; int ldu;
    __device__ __forceinline__ void operator()(const f32x4 (&acc)[2][2][4][2], const Unit& u, int wr, int wc, int fr, int fq) const {
        const int row0 = u.pm * BM + wr * 64 + fr, col0 = u.pn * 128 + wc * 32 + 8 * fq;
#pragma unroll
        for (int ai = 0; ai < 2; ++ai)
#pragma unroll
            for (int m = 0; m < 4; ++m) {
                float o[8];
#pragma unroll
                for (int n = 0; n < 2; ++n)
#pragma unroll
                    for (int e = 0; e < 4; ++e) o[4 * n + e] = silu(acc[ai][0][m][n][e]) * acc[ai][1][m][n][e];
                *(u32x4*)(U + (size_t)(row0 + ai * HALF + m * 16) * ldu + col0) = pack8(o);
            }
    }
};
struct EpiRes {
    static constexpr bool PERM = false, AFTER_DRAIN = false;
    const float* xin; float* xout; const float* gate; float scale;
    __device__ __forceinline__ void operator()(const f32x4 (&acc)[2][2][4][2], const Unit& u, int wr, int wc, int fr, int fq) const {
        const int b = u.pm >> 3, col0 = u.pn * BM + wc * 32 + 4 * fq;
        f32x4 gv[2][2];
#pragma unroll
        for (int bj = 0; bj < 2; ++bj)
#pragma unroll
            for (int n = 0; n < 2; ++n) gv[bj][n] = *(const f32x4*)(gate + (size_t)b * 9216 + col0 + bj * HALF + n * 16) * scale;
#pragma unroll
        for (int ai = 0; ai < 2; ++ai)
#pragma unroll
            for (int m = 0; m < 4; ++m) { const size_t off = (size_t)(u.pm * BM + ai * HALF + wr * 64 + m * 16 + fr) * 1024 + col0;
#pragma unroll
                for (int bj = 0; bj < 2; ++bj)
#pragma unroll
                    for (int n = 0; n < 2; ++n) { const f32x4 xi = *(const f32x4*)(xin + off + bj * HALF + n * 16); *(f32x4*)(xout + off + bj * HALF + n * 16) = xi + gv[bj][n] * acc[ai][bj][m][n]; } }
    }
};
struct EpiIn {
    static constexpr bool PERM = true, AFTER_DRAIN = false;
    bf16_t *QA, *KA, *VA, *QR, *KR, *VR, *RG, *GA, *GR; const float *gq, *gk, *bmerge, *cosA, *sinA, *cosR, *sinR; float qscale;
    __device__ __forceinline__ void operator()(const f32x4 (&acc)[2][2][4][2], const Unit& u, int wr, int wc, int fr, int fq) const {
        const int pn = u.pn, row0 = u.pm * BM + wr * 64 + fr, d0 = 8 * fq;
        if (pn < 4) {
            const bool isq = pn < 2; bf16_t* dst = isq ? QA : KA; const float* g = isq ? gq : gk; const float osc = isq ? qscale : 1.f;
            const int hh = 4 * (pn & 1) + wc;
            float g0[8], g1[8];
#pragma unroll
            for (int e = 0; e < 8; ++e) { g0[e] = g[d0 + e]; g1[e] = g[32 + d0 + e]; }
#pragma unroll
            for (int ai = 0; ai < 2; ++ai)
#pragma unroll
                for (int m = 0; m < 4; ++m) { const int row = row0 + ai * HALF + m * 16;
                    float x0[8], x1[8], ss = 0.f;
#pragma unroll
                    for (int n = 0; n < 2; ++n)
#pragma unroll
                        for (int e = 0; e < 4; ++e) { x0[4 * n + e] = acc[ai][0][m][n][e]; x1[4 * n + e] = acc[ai][1][m][n][e]; }
#pragma unroll
                    for (int e = 0; e < 8; ++e) ss += x0[e] * x0[e] + x1[e] * x1[e];
                    ss += __shfl_xor(ss, 16); ss += __shfl_xor(ss, 32);
                    const float rstd = __builtin_amdgcn_rsqf(ss * (1.f / 64.f) + 1e-6f);
                    const f32x4 c0 = *(const f32x4*)(cosA + (size_t)row * 32 + d0), c1 = *(const f32x4*)(cosA + (size_t)row * 32 + d0 + 4);
                    const f32x4 s0 = *(const f32x4*)(sinA + (size_t)row * 32 + d0), s1 = *(const f32x4*)(sinA + (size_t)row * 32 + d0 + 4);
                    float o0[8], o1[8];
#pragma unroll
                    for (int e = 0; e < 8; ++e) { const float c = e < 4 ? c0[e & 3] : c1[e & 3], s = e < 4 ? s0[e & 3] : s1[e & 3];
                        const float a = x0[e] * rstd * g0[e], bb = x1[e] * rstd * g1[e]; o0[e] = (a * c - bb * s) * osc; o1[e] = (bb * c + a * s) * osc; }
                    bf16_t* p = dst + (size_t)row * 512 + 64 * hh + d0;
                    *(u32x4*)p = pack8(o0); *(u32x4*)(p + 32) = pack8(o1); }
        } else if (pn == 6 || pn == 7) {
            bf16_t* dst = pn == 6 ? QR : KR; const float osc = pn == 6 ? 1.f : 0.125f;
#pragma unroll
            for (int ai = 0; ai < 2; ++ai)
#pragma unroll
                for (int m = 0; m < 4; ++m) { const int row = row0 + ai * HALF + m * 16;
                    const f32x4 c0 = *(const f32x4*)(cosR + (size_t)row * 32 + d0), c1 = *(const f32x4*)(cosR + (size_t)row * 32 + d0 + 4);
                    const f32x4 s0 = *(const f32x4*)(sinR + (size_t)row * 32 + d0), s1 = *(const f32x4*)(sinR + (size_t)row * 32 + d0 + 4);
                    float o0[8], o1[8];
#pragma unroll
                    for (int n = 0; n < 2; ++n)
#pragma unroll
                        for (int e = 0; e < 4; ++e) { const float c = n == 0 ? c0[e] : c1[e], s = n == 0 ? s0[e] : s1[e]; const float xe = acc[ai][0][m][n][e], xo = acc[ai][1][m][n][e];
                            o0[4 * n + e] = (xe * c - xo * s) * osc; o1[4 * n + e] = (xo * c + xe * s) * osc; }
                    bf16_t* p = dst + (size_t)row * 256 + 64 * wc + d0;
                    *(u32x4*)p = pack8(o0); *(u32x4*)(p + 32) = pack8(o1); }
        } else {
            bf16_t* dst; int ld, cb, op; const float* bias = nullptr;
            if (pn < 6) { dst = VA; ld = 512; cb = 256 * (pn - 4); op = 0; }
            else if (pn < 10) { dst = VR; ld = 512; cb = 256 * (pn - 8); op = 0; }
            else if (pn < 12) { dst = RG; ld = 512; cb = 256 * (pn - 10); op = 1; }
            else if (pn < 16) { dst = GA; ld = 1024; cb = 256 * (pn - 12); op = 2; bias = bmerge; }
            else { dst = GR; ld = 1024; cb = 256 * (pn - 16); op = 2; bias = bmerge + 1024; }
#pragma unroll
            for (int bj = 0; bj < 2; ++bj) { const int col = cb + bj * HALF + wc * 32 + d0;
                f32x4 b0 = (f32x4){0.f, 0.f, 0.f, 0.f}, b1 = b0; if (op == 2) { b0 = *(const f32x4*)(bias + col); b1 = *(const f32x4*)(bias + col + 4); }
#pragma unroll
                for (int ai = 0; ai < 2; ++ai)
#pragma unroll
                    for (int m = 0; m < 4; ++m) { const int row = row0 + ai * HALF + m * 16; float o[8];
#pragma unroll
                        for (int e = 0; e < 4; ++e) { float v0 = acc[ai][bj][m][0][e] + b0[e], v1 = acc[ai][bj][m][1][e] + b1[e];
                            if (op == 1) { v0 = silu(v0); v1 = silu(v1); } else if (op == 2) { v0 = sigm(v0); v1 = sigm(v1); }
                            o[e] = v0; o[4 + e] = v1; }
                        *(u32x4*)(dst + (size_t)row * ld + col) = pack8(o); } }
        }
    }
};
template <int MODE> struct EpiBr {
    static constexpr bool PERM = true, AFTER_DRAIN = false;
    bf16_t* T; const bf16_t* G;
    __device__ __forceinline__ void operator()(const f32x4 (&acc)[2][2][4][2], const Unit& u, int wr, int wc, int fr, int fq) const {
        const int row0 = u.pm * BM + wr * 64 + fr, col0 = u.pn * BM + wc * 32 + 8 * fq;
#pragma unroll
        for (int ai = 0; ai < 2; ++ai)
#pragma unroll
            for (int m = 0; m < 4; ++m)
#pragma unroll
                for (int bj = 0; bj < 2; ++bj) { const size_t off = (size_t)(row0 + ai * HALF + m * 16) * 1024 + col0 + bj * HALF;
                    const u32x4 gw = *(const u32x4*)(G + off); u32x4 tw = (u32x4){0u, 0u, 0u, 0u}; if (MODE == 1) tw = *(const u32x4*)(T + off);
                    const f32x4 a0 = acc[ai][bj][m][0], a1 = acc[ai][bj][m][1]; float o[8];
                    o[0] = bflo(gw.x) * a0[0]; o[1] = bfhi(gw.x) * a0[1]; o[2] = bflo(gw.y) * a0[2]; o[3] = bfhi(gw.y) * a0[3];
                    o[4] = bflo(gw.z) * a1[0]; o[5] = bfhi(gw.z) * a1[1]; o[6] = bflo(gw.w) * a1[2]; o[7] = bfhi(gw.w) * a1[3];
                    if (MODE == 1) { o[0] += bflo(tw.x); o[1] += bfhi(tw.x); o[2] += bflo(tw.y); o[3] += bfhi(tw.y); o[4] += bflo(tw.z); o[5] += bfhi(tw.z); o[6] += bflo(tw.w); o[7] += bfhi(tw.w); }
                    *(u32x4*)(T + off) = pack8(o); }
    }
};
template <class Epi, class Sched, bool ALIGN_EPI = false, bool SP2 = false>
__device__ __forceinline__ void gemm_phase(PG8_LAS unsigned char* lds, const Gemm g, const Sched& S, const Epi& E) {
    const int tid = threadIdx.x, wid = __builtin_amdgcn_readfirstlane(tid >> 6), lane = tid & 63, wr = wid >> 2, wc = wid & 3, fr = lane & 15, fq = lane >> 4;
    const int K = g.K, nt = K / BK;
    unsigned voffA[2], voffB[2];
#pragma unroll
    for (int i = 0; i < 2; ++i) { int R, C; stage_rc(tid * 16 + i * 8192, R, C); const int Rb = Epi::PERM ? ((R & ~31) + perm32(R & 31)) : R;
        voffA[i] = (unsigned)(R * K + C) * 2u; voffB[i] = (unsigned)(Rb * K + C) * 2u; }
    const size_t kstep = (size_t)(BK * 2);
    const size_t hstep = (size_t)HALF * K * 2;
    const size_t tstep = 2 * hstep;
    const unsigned ldsw = (unsigned)wid * 1024u;
    const int aoff = lds_byte(wr * 64 + fr, fq * 8), boff = lds_byte(wc * 32 + fr, fq * 8);
#define PG8_SA(b, h) (((b) * 2 + (h)) * HTB)
#define PG8_SB(b, h) ((4 + (b) * 2 + (h)) * HTB)
#define PG8_STAGE(bufoff, gbase, voff) do { _Pragma("unroll") for (int _i = 0; _i < 2; ++_i) \
        __builtin_amdgcn_global_load_lds((const unsigned*)((const char*)(gbase) + (voff)[_i]), (PG8_LAS unsigned*)(lds + (bufoff) + ldsw + _i * 8192), 16, 0, 0); } while (0)
#define PG8_LDA(dst, b, h) do { _Pragma("unroll") for (int m = 0; m < 4; ++m) _Pragma("unroll") for (int k = 0; k < 2; ++k) dst[m][k] = *(const PG8_LAS bf16x8*)(lds + PG8_SA(b, h) + aoff + m * 2048 + k * 1024); } while (0)
#define PG8_LDB(dst, b, h) do { _Pragma("unroll") for (int n = 0; n < 2; ++n) _Pragma("unroll") for (int k = 0; k < 2; ++k) dst[n][k] = *(const PG8_LAS bf16x8*)(lds + PG8_SB(b, h) + boff + n * 2048 + k * 1024); } while (0)
#define PG8_MMA(ai, bj, At, Bt) do { __builtin_amdgcn_s_setprio(1); _Pragma("unroll") for (int m = 0; m < 4; ++m) _Pragma("unroll") for (int n = 0; n < 2; ++n) _Pragma("unroll") for (int k = 0; k < 2; ++k) \
        acc[ai][bj][m][n] = __builtin_amdgcn_mfma_f32_16x16x32_bf16(Bt[n][k], At[m][k], acc[ai][bj][m][n], 0, 0, 0); __builtin_amdgcn_s_setprio(0); } while (0)
#define PG8_WAIT_V(n) asm volatile("s_waitcnt vmcnt(" #n ")" ::: "memory")
#define PG8_WAIT_L(n) asm volatile("s_waitcnt lgkmcnt(" #n ")" ::: "memory")
#define PG8_BAR __builtin_amdgcn_s_barrier()
#define PG8_SCHED __builtin_amdgcn_sched_barrier(0)
    Unit cur, nxt; int ui = 0;
    if (!S.next(0, cur)) return;
    f32x4 acc[2][2][4][2];
#pragma unroll
    for (int a = 0; a < 2; ++a)
#pragma unroll
        for (int b = 0; b < 2; ++b)
#pragma unroll
            for (int m = 0; m < 4; ++m)
#pragma unroll
                for (int n = 0; n < 2; ++n) acc[a][b][m][n] = (f32x4){0.f, 0.f, 0.f, 0.f};
    bf16x8 At[4][2], B0[2][2], B1[2][2];
    const char* cA = (const char*)g.A + (size_t)cur.pm * tstep; const char* cB = (const char*)g.Bt + (size_t)cur.pn * tstep;
    S.a_ready(cur);
    if constexpr (SP2) {
        PG8_STAGE(PG8_SB(0, 0), cB, voffB); PG8_STAGE(PG8_SB(0, 1), cB + hstep, voffB); PG8_STAGE(PG8_SA(0, 0), cA, voffA); PG8_STAGE(PG8_SA(0, 1), cA + hstep, voffA);
        if (wr == 1) PG8_BAR;
        PG8_WAIT_V(2); PG8_BAR;
        PG8_STAGE(PG8_SB(1, 0), cB + kstep, voffB); PG8_STAGE(PG8_SA(1, 0), cA + kstep, voffA); PG8_STAGE(PG8_SB(1, 1), cB + hstep + kstep, voffB);
        PG8_WAIT_V(6); PG8_BAR;
    } else {
        PG8_STAGE(PG8_SB(0, 0), cB, voffB); PG8_STAGE(PG8_SA(0, 0), cA, voffA); PG8_STAGE(PG8_SB(0, 1), cB + hstep, voffB); PG8_STAGE(PG8_SA(0, 1), cA + hstep, voffA);
        if (wr == 1) PG8_BAR;
        PG8_WAIT_V(4); PG8_BAR;
        PG8_STAGE(PG8_SB(1, 0), cB + kstep, voffB); PG8_STAGE(PG8_SA(1, 0), cA + kstep, voffA); PG8_STAGE(PG8_SB(1, 1), cB + hstep + kstep, voffB);
        PG8_WAIT_V(6); PG8_BAR;
    }
    for (;;) {
        const bool has_next = S.next(ui + 1, nxt);
        const char* nA = has_next ? (const char*)g.A + (size_t)nxt.pm * tstep : cA; const char* nB = has_next ? (const char*)g.Bt + (size_t)nxt.pn * tstep : cB;
        for (int t = 0; t < nt; t += 2) {
            const bool last = (t == nt - 2);
            const char* a1 = cA + (size_t)(t + 1) * kstep;
            const char* a2 = last ? nA : cA + (size_t)(t + 2) * kstep; const char* b2 = last ? nB : cB + (size_t)(t + 2) * kstep;
            const char* a3 = a2 + kstep; const char* b3 = b2 + kstep;
            if (last && has_next) S.a_ready(nxt);
            if constexpr (SP2) {
            PG8_LDB(B0, 0, 0); PG8_LDB(B1, 0, 1); PG8_SCHED; PG8_LDA(At, 0, 0); PG8_STAGE(PG8_SA(1, 1), a1 + hstep, voffA);
            PG8_WAIT_V(8); PG8_WAIT_L(0); PG8_BAR; PG8_MMA(0, 0, At, B0); PG8_MMA(0, 1, At, B1); PG8_BAR; PG8_SCHED;
            PG8_LDA(At, 0, 1); PG8_STAGE(PG8_SB(0, 0), b2, voffB); PG8_STAGE(PG8_SB(0, 1), b2 + hstep, voffB); PG8_STAGE(PG8_SA(0, 0), a2, voffA);
            PG8_WAIT_V(8); PG8_WAIT_L(0); PG8_BAR; PG8_MMA(1, 0, At, B0); PG8_MMA(1, 1, At, B1); PG8_BAR; PG8_SCHED;
            PG8_LDB(B0, 1, 0); PG8_LDB(B1, 1, 1); PG8_SCHED; PG8_LDA(At, 1, 0); PG8_STAGE(PG8_SA(0, 1), a2 + hstep, voffA);
            PG8_WAIT_V(8); PG8_WAIT_L(0); PG8_BAR; PG8_MMA(0, 0, At, B0); PG8_MMA(0, 1, At, B1); PG8_BAR; PG8_SCHED;
            PG8_LDA(At, 1, 1); PG8_STAGE(PG8_SB(1, 0), b3, voffB); PG8_STAGE(PG8_SB(1, 1), b3 + hstep, voffB); PG8_STAGE(PG8_SA(1, 0), a3, voffA);
            PG8_WAIT_V(8); PG8_WAIT_L(0); PG8_BAR; PG8_MMA(1, 0, At, B0); PG8_MMA(1, 1, At, B1); PG8_BAR; PG8_SCHED;
            } else {
            PG8_LDB(B0, 0, 0); PG8_SCHED; PG8_LDA(At, 0, 0); PG8_STAGE(PG8_SA(1, 1), a1 + hstep, voffA);
            PG8_WAIT_L(8); PG8_BAR; PG8_WAIT_L(0); PG8_MMA(0, 0, At, B0); PG8_BAR; PG8_SCHED;
            PG8_LDB(B1, 0, 1); PG8_STAGE(PG8_SB(0, 0), b2, voffB);
            PG8_BAR; PG8_WAIT_L(0); PG8_MMA(0, 1, At, B1); PG8_BAR;
            PG8_LDA(At, 0, 1); PG8_STAGE(PG8_SA(0, 0), a2, voffA);
            PG8_BAR; PG8_WAIT_L(0); PG8_MMA(1, 0, At, B0); PG8_BAR; PG8_SCHED;
            PG8_STAGE(PG8_SB(0, 1), b2 + hstep, voffB);
            PG8_WAIT_V(6); PG8_BAR; PG8_MMA(1, 1, At, B1); PG8_BAR;
            PG8_LDB(B0, 1, 0); PG8_SCHED; PG8_LDA(At, 1, 0); PG8_STAGE(PG8_SA(0, 1), a2 + hstep, voffA);
            PG8_WAIT_L(8); PG8_BAR; PG8_WAIT_L(0); PG8_MMA(0, 0, At, B0); PG8_BAR; PG8_SCHED;
            PG8_LDB(B1, 1, 1); PG8_STAGE(PG8_SB(1, 0), b3, voffB);
            PG8_BAR; PG8_WAIT_L(0); PG8_MMA(0, 1, At, B1); PG8_BAR;
            PG8_LDA(At, 1, 1); PG8_STAGE(PG8_SA(1, 0), a3, voffA);
            PG8_BAR; PG8_WAIT_L(0); PG8_MMA(1, 0, At, B0); PG8_BAR; PG8_SCHED;
            PG8_STAGE(PG8_SB(1, 1), b3 + hstep, voffB);
            PG8_WAIT_V(6); PG8_BAR; PG8_MMA(1, 1, At, B1); PG8_BAR;
            }
        }
        if constexpr (ALIGN_EPI) { if (wr == 0) PG8_BAR; }
        if constexpr (!Epi::AFTER_DRAIN) { E(acc, cur, wr, wc, fr, fq); S.done(cur); }
        if (!has_next) break;
#pragma unroll
        for (int a = 0; a < 2; ++a)
#pragma unroll
            for (int b = 0; b < 2; ++b)
#pragma unroll
                for (int m = 0; m < 4; ++m)
#pragma unroll
                    for (int n = 0; n < 2; ++n) acc[a][b][m][n] = (f32x4){0.f, 0.f, 0.f, 0.f};
        cur = nxt; cA = nA; cB = nB; ++ui;
        if constexpr (ALIGN_EPI) { if (wr == 1) PG8_BAR; }
    }
    PG8_WAIT_V(0);
    if constexpr (!ALIGN_EPI) { if (wr == 0) PG8_BAR; }
    PG8_BAR;
    if constexpr (Epi::AFTER_DRAIN) { E.fused(acc, cur, wr, wc, fr, fq, lds, wid, lane); S.done(cur); }
#undef PG8_SA
#undef PG8_SB
#undef PG8_STAGE
#undef PG8_LDA
#undef PG8_LDB
#undef PG8_MMA
#undef PG8_WAIT_V
#undef PG8_WAIT_L
#undef PG8_BAR
#undef PG8_SCHED
}
}
#define LAS __attribute__((address_space(3)))
typedef unsigned short bf16;
typedef unsigned u32x4 __attribute__((ext_vector_type(4)));
typedef float f32x4 __attribute__((ext_vector_type(4)));
typedef float f32x16 __attribute__((ext_vector_type(16)));
typedef short bf16x8 __attribute__((ext_vector_type(8)));
typedef short s16x4 __attribute__((ext_vector_type(4)));
typedef unsigned char uchar;
constexpr int NWAVES = 8;
constexpr int BATCH = 8, SEQ = 2048, D = 1024, FF = 2816, NIN = 5120, M = BATCH * SEQ, NMOD = 9 * D;
constexpr float LOG2E = 1.4426950408889634f;
constexpr float QSCALE = 0.125f * LOG2E;
constexpr size_t MiB = 1u << 20;
constexpr size_t WS_CTL = 0, CTL_ZERO_BYTES = 1 * MiB, WS_MOD = 65536;
constexpr size_t WS_W13A = 2 * MiB, WS_W2A = 13 * MiB, WS_WIN = 19 * MiB, WS_WA = 29 * MiB, WS_WR = 30 * MiB, WS_WO = 31 * MiB, WS_W13B = 33 * MiB, WS_W2B = 44 * MiB;
constexpr size_t WS_TAB = 50 * MiB;
constexpr size_t WS_H = 58 * MiB;
constexpr size_t WS_Z = 90 * MiB;
constexpr size_t WS_QA = WS_Z, WS_KA = WS_Z + 16 * MiB, WS_VA = WS_Z + 32 * MiB, WS_QR = WS_Z + 48 * MiB, WS_KR = WS_Z + 56 * MiB, WS_VR = WS_Z + 64 * MiB, WS_RG = WS_Z + 80 * MiB, WS_GA = WS_Z + 96 * MiB, WS_GR = WS_Z + 128 * MiB;
constexpr size_t WS_T = WS_KA;
constexpr size_t WS_END = 250 * MiB;
constexpr int RING_BYTES = 131072, LDS_BYTES = 147456;

#define LDS_WAIT() asm volatile("s_waitcnt lgkmcnt(0)" ::: "memory")
__device__ __forceinline__ unsigned cvtpk(float lo, float hi) { unsigned r; asm volatile("v_cvt_pk_bf16_f32 %0, %1, %2" : "=v"(r) : "v"(lo), "v"(hi)); return r; }
__device__ __forceinline__ float bf2f(unsigned short v) { return __uint_as_float((unsigned)v << 16); }
__device__ __forceinline__ unsigned short f2bf(float f) { return (unsigned short)(cvtpk(f, 0.f) & 0xffffu); }
__device__ __forceinline__ float wave_sum(float v) {
#pragma unroll
    for (int o = 1; o < 64; o <<= 1) v += __shfl_xor(v, o);
    return v;
}
__device__ __forceinline__ float ex2(float v) { return __builtin_amdgcn_exp2f(v); }

struct Args { const float* in[29]; float* out; unsigned char* ws; int ph_lo, ph_hi; };

__device__ __forceinline__ void tr_item(const float* W, int Nsrc, int scol0, int cstride, int k0, bf16* WT, int Kdst, int drow0, LAS float* scr, int lane) {
#pragma unroll 8
    for (int i = 0; i < 32; ++i) { const int kk = 2 * i + (lane >> 5); scr[kk * 33 + (lane & 31)] = W[(size_t)(k0 + kk) * Nsrc + scol0 + (lane & 31) * cstride]; }
    LDS_WAIT(); asm volatile("" ::: "memory");
    const int c = lane & 7;
#pragma unroll
    for (int j = 0; j < 4; ++j) { const int n = (lane >> 3) + 8 * j; const LAS float* s = scr + (8 * c) * 33 + n;
        u32x4 o; o.x = cvtpk(s[0 * 33], s[1 * 33]); o.y = cvtpk(s[2 * 33], s[3 * 33]); o.z = cvtpk(s[4 * 33], s[5 * 33]); o.w = cvtpk(s[6 * 33], s[7 * 33]);
        *(u32x4*)(WT + (size_t)(drow0 + n) * Kdst + k0 + 8 * c) = o; }
    LDS_WAIT(); asm volatile("" ::: "memory");
}
__device__ __forceinline__ void tr_w13(const float* w1, const float* w3, bf16* WT, int it, LAS float* scr, int lane) {
    const int kb = it / 176, nb = it % 176, n0 = 32 * nb, pn = n0 >> 8, bj = (n0 >> 7) & 1, j0 = n0 & 127;
    tr_item(bj ? w3 : w1, FF, 128 * pn + j0, 1, 64 * kb, WT, D, n0, scr, lane);
}
__device__ __forceinline__ void tr_plain(const float* W, int K, int N, bf16* WT, int it, LAS float* scr, int lane) {
    const int nblk = N / 32, kb = it / nblk, nb = it % nblk;
    tr_item(W, N, 32 * nb, 1, 64 * kb, WT, K, 32 * nb, scr, lane);
}
__device__ __forceinline__ void tr_win(const float* W, bf16* WT, int it, LAS float* scr, int lane) {
    const int kb = it / 160, nb = it % 160, n0 = 32 * nb, pn = n0 >> 8, bj = (n0 >> 7) & 1, wc = (n0 >> 5) & 3;
    int scol0 = n0, cs = 1;
    if (pn < 4) scol0 = 256 * pn + 64 * wc + 32 * bj;
    else if (pn == 6 || pn == 7) { scol0 = 256 * pn + 64 * wc + bj; cs = 2; }
    tr_item(W, NIN, scol0, cs, 64 * kb, WT, D, n0, scr, lane);
}
__device__ __forceinline__ void norm_phase(const float* xin, const float* g, const float* sh, const float* sc, bf16* H, int gw, int NGW, int lane) {
    for (int rb = gw; rb < M / 8; rb += NGW) {
        const int b = rb >> 8;
        f32x4 A[4], Bv[4];
#pragma unroll
        for (int j = 0; j < 4; ++j) { const int col = 4 * lane + 256 * j; const f32x4 gg = *(const f32x4*)(g + col), s1 = *(const f32x4*)(sc + (size_t)b * NMOD + col); A[j] = gg * (s1 + 1.0f); Bv[j] = *(const f32x4*)(sh + (size_t)b * NMOD + col); }
#pragma unroll 2
        for (int r = 0; r < 8; ++r) { const size_t row = (size_t)rb * 8 + r;
            f32x4 v[4]; float ss = 0.f;
#pragma unroll
            for (int j = 0; j < 4; ++j) { v[j] = *(const f32x4*)(xin + row * D + 4 * lane + 256 * j); ss += (v[j].x * v[j].x + v[j].y * v[j].y) + (v[j].z * v[j].z + v[j].w * v[j].w); }
            const float rstd = __builtin_amdgcn_rsqf(wave_sum(ss) * (1.f / D) + 1e-6f);
#pragma unroll
            for (int j = 0; j < 4; ++j) { const f32x4 o = v[j] * rstd * A[j] + Bv[j];
                unsigned long long w = (unsigned long long)cvtpk(o.x, o.y) | ((unsigned long long)cvtpk(o.z, o.w) << 32);
                *(unsigned long long*)(H + row * D + 4 * lane + 256 * j) = w; } }
    }
}

__device__ __forceinline__ s16x4 vtr(LAS const uchar* p) { return __builtin_amdgcn_ds_read_tr16_b64_v4i16((LAS s16x4*)p); }
__device__ __forceinline__ int crow(int r, int hi) { return (r & 3) + 8 * (r >> 2) + 4 * hi; }
__device__ __forceinline__ int voff(int row, int ch) { return 256 * row + 16 * (ch ^ (((row & 3) << 2) | ((row >> 2) & 3))); }
__device__ __forceinline__ int koff(int row, int ch) { return 128 * row + 16 * (ch ^ ((row >> 1) & 7)); }
__device__ __forceinline__ bf16x8 vfrag(LAS const uchar* vb, int ks, int c, int lane) {
    const int hi = lane >> 5, g1 = (lane >> 4) & 1, li = lane & 15, q = li >> 2, p = li & 3;
    const int ch = 4 * c + 2 * g1 + (p >> 1), r0 = 16 * ks + 4 * hi + q;
    const s16x4 lo = vtr(vb + voff(r0, ch) + 8 * (p & 1)), h4 = vtr(vb + voff(r0 + 8, ch) + 8 * (p & 1));
    return (bf16x8){lo[0], lo[1], lo[2], lo[3], h4[0], h4[1], h4[2], h4[3]};
}
__device__ __forceinline__ bf16x8 pack8f(const f32x16& p, int base) {
    u32x4 w; w.x = cvtpk(p[base + 0], p[base + 1]); w.y = cvtpk(p[base + 2], p[base + 3]); w.z = cvtpk(p[base + 4], p[base + 5]); w.w = cvtpk(p[base + 6], p[base + 7]);
    return __builtin_bit_cast(bf16x8, w);
}
#define MFMA32(a, b, c) __builtin_amdgcn_mfma_f32_32x32x16_bf16((a), (b), (c), 0, 0, 0)

__device__ __forceinline__ void attn_unit(LAS uchar* lds, int b, int h, int qb, const bf16* QA, const bf16* KA, const bf16* VA, bf16* OA, float negC, float lam, const float* subln) {
    const int tid = threadIdx.x, lane = tid & 63, wid = __builtin_amdgcn_readfirstlane(tid >> 6), qg = wid & 3, mp = wid >> 2, r32 = lane & 31, hi = lane >> 5;
    const size_t tokb = (size_t)b * SEQ; const int q0 = qb * 128 + qg * 32;
    bf16x8 qf[4];
    { const bf16* qp = QA + (tokb + q0 + r32) * 512 + h * 128 + mp * 64 + hi * 8;
#pragma unroll
      for (int s = 0; s < 4; ++s) qf[s] = *(const bf16x8*)(qp + 16 * s); }
    const int krow = tid >> 3, kch = tid & 7, vrow0 = tid >> 4, vch = tid & 15;
    const bf16* kg0 = KA + (tokb + krow) * 512 + h * 128 + kch * 8;
    const bf16* vg0 = VA + (tokb + vrow0) * 512 + h * 128 + vch * 8;
    const int kl = koff(krow, kch), vl0 = voff(vrow0, vch), vl1 = voff(vrow0 + 32, vch);
    u32x4 sk0, sk1, sv0, sv1;
#define AT_LOAD(t) do { const size_t o_ = (size_t)(t) * 64 * 512; sk0 = *(const u32x4*)(kg0 + o_); sk1 = *(const u32x4*)(kg0 + o_ + 64); sv0 = *(const u32x4*)(vg0 + o_); sv1 = *(const u32x4*)(vg0 + o_ + 32 * 512); } while (0)
#define AT_STORE(buf) do { LAS uchar* bb_ = lds + (buf) * 32768; *(LAS u32x4*)(bb_ + kl) = sk0; *(LAS u32x4*)(bb_ + 8192 + kl) = sk1; *(LAS u32x4*)(bb_ + 16384 + vl0) = sv0; *(LAS u32x4*)(bb_ + 16384 + vl1) = sv1; } while (0)
    AT_LOAD(0); AT_STORE(0); __syncthreads();
    f32x16 o[4];
#pragma unroll
    for (int c = 0; c < 4; ++c)
#pragma unroll
        for (int r = 0; r < 16; ++r) o[c][r] = 0.f;
    float lsum = 0.f;
    for (int kt = 0; kt < SEQ / 64; ++kt) {
        const int cur = kt & 1;
        if (kt + 1 < SEQ / 64) AT_LOAD(kt + 1);
        LAS const uchar* kb = lds + cur * 32768 + mp * 8192; LAS const uchar* vb = lds + cur * 32768 + 16384;
        f32x16 p0, p1;
#pragma unroll
        for (int r = 0; r < 16; ++r) { p0[r] = negC; p1[r] = negC; }
#pragma unroll
        for (int s = 0; s < 4; ++s) { const bf16x8 k0 = *(LAS const bf16x8*)(kb + koff(r32, 2 * s + hi)), k1 = *(LAS const bf16x8*)(kb + koff(32 + r32, 2 * s + hi));
            p0 = MFMA32(k0, qf[s], p0); p1 = MFMA32(k1, qf[s], p1); }
        float sa = 0.f, sb = 0.f;
#pragma unroll
        for (int r = 0; r < 16; ++r) { p0[r] = ex2(p0[r]); p1[r] = ex2(p1[r]); sa += p0[r]; sb += p1[r]; }
        lsum += sa + sb;
        const bf16x8 pw0 = pack8f(p0, 0), pw1 = pack8f(p0, 8), pw2 = pack8f(p1, 0), pw3 = pack8f(p1, 8);
#pragma unroll
        for (int c = 0; c < 4; ++c) {
            o[c] = MFMA32(pw0, vfrag(vb, 0, c, lane), o[c]); o[c] = MFMA32(pw1, vfrag(vb, 1, c, lane), o[c]);
            o[c] = MFMA32(pw2, vfrag(vb, 2, c, lane), o[c]); o[c] = MFMA32(pw3, vfrag(vb, 3, c, lane), o[c]);
 }
        if (kt + 1 < SEQ / 64) AT_STORE(cur ^ 1);
        __syncthreads();
    }
#undef AT_LOAD
#undef AT_STORE
    lsum += __shfl_xor(lsum, 32);
    LAS float* lb = (LAS float*)(lds + 98304) + wid * 32;
    if (hi == 0) lb[r32] = (mp ? lam : 1.f) / lsum;
    LDS_WAIT(); asm volatile("" ::: "memory");
    float rl[16];
#pragma unroll
    for (int r = 0; r < 16; ++r) rl[r] = lb[crow(r, hi)];
    LAS float* X = (LAS float*)lds + qg * 4096;
    if (mp == 1) {
#pragma unroll
        for (int c = 0; c < 4; ++c)
#pragma unroll
            for (int r = 0; r < 16; ++r) X[crow(r, hi) * 128 + 32 * c + r32] = o[c][r] * rl[r];
    }
    __syncthreads();
    if (mp == 0) {
        float ssq[16];
#pragma unroll
        for (int r = 0; r < 16; ++r) ssq[r] = 0.f;
#pragma unroll
        for (int c = 0; c < 4; ++c)
#pragma unroll
            for (int r = 0; r < 16; ++r) { const float v = o[c][r] * rl[r] - X[crow(r, hi) * 128 + 32 * c + r32]; o[c][r] = v; ssq[r] += v * v; }
#pragma unroll
        for (int r = 0; r < 16; ++r) {
#pragma unroll
            for (int x = 1; x < 32; x <<= 1) ssq[r] += __shfl_xor(ssq[r], x);
            ssq[r] = __builtin_amdgcn_rsqf(ssq[r] * (1.f / 128.f) + 1e-6f) * 0.8f; }
#pragma unroll
        for (int c = 0; c < 4; ++c) { const float sg = subln[32 * c + r32];
#pragma unroll
            for (int r = 0; r < 16; ++r) OA[(tokb + q0 + crow(r, hi)) * 512 + h * 128 + 32 * c + r32] = f2bf(o[c][r] * ssq[r] * sg); }
    }
    __syncthreads();
}

__device__ __forceinline__ void ret_state_task(LAS uchar* wl, int task, const bf16* KR, const bf16* VR, bf16* RT, const float* dec_f, const float* dec_b, int lane) {
    const int dt = task & 3, et = (task >> 2) & 7, dir = (task >> 5) & 1, h = (task >> 6) & 3, b = task >> 8;
    const float x = dir ? dec_b[h] : dec_f[h];
    const float lg2 = -log1pf(expf(-x)) * LOG2E, decay = ex2(128.f * lg2);
    f32x4 st = (f32x4){0.f, 0.f, 0.f, 0.f};
    const int g = lane >> 4, li = lane & 15, q = li >> 2, p = li & 3, hc = lane & 1;
    for (int step = 0; step < 16; ++step) {
        const int n = dir ? 15 - step : step;
        bf16* rt = RT + ((((size_t)(b * 4 + h) * 2 + dir) * 16 + n) * 128 + 16 * et) * 64 + 16 * dt;
#pragma unroll
        for (int r = 0; r < 4; ++r) rt[(4 * g + r) * 64 + li] = f2bf(st[r]);
        if (step == 15) break;
        const size_t tok0 = (size_t)b * SEQ + n * 128;
#pragma unroll
        for (int i = 0; i < 4; ++i) { const int row = 32 * i + (lane >> 1);
            const u32x4 vv = *(const u32x4*)(VR + (tok0 + row) * 512 + 128 * h + 16 * et + 8 * hc);
            const u32x4 kk = *(const u32x4*)(KR + (tok0 + row) * 256 + 64 * h + 16 * dt + 8 * hc);
            const float z = dir ? ex2((float)row * lg2) : ex2((float)(127 - row) * lg2);
            u32x4 ks; ks.x = cvtpk(pg8::bflo(kk.x) * z, pg8::bfhi(kk.x) * z); ks.y = cvtpk(pg8::bflo(kk.y) * z, pg8::bfhi(kk.y) * z); ks.z = cvtpk(pg8::bflo(kk.z) * z, pg8::bfhi(kk.z) * z); ks.w = cvtpk(pg8::bflo(kk.w) * z, pg8::bfhi(kk.w) * z);
            *(LAS u32x4*)(wl + row * 32 + 16 * hc) = vv; *(LAS u32x4*)(wl + 4096 + row * 32 + 16 * hc) = ks; }
        f32x4 acc = (f32x4){0.f, 0.f, 0.f, 0.f};
#pragma unroll
        for (int s = 0; s < 4; ++s) { const int ra = 32 * s + 8 * g + q;
            const s16x4 a0 = vtr(wl + ra * 32 + 8 * p), a1 = vtr(wl + (ra + 4) * 32 + 8 * p), b0 = vtr(wl + 4096 + ra * 32 + 8 * p), b1 = vtr(wl + 4096 + (ra + 4) * 32 + 8 * p);
            const bf16x8 A = (bf16x8){a0[0], a0[1], a0[2], a0[3], a1[0], a1[1], a1[2], a1[3]}, B = (bf16x8){b0[0], b0[1], b0[2], b0[3], b1[0], b1[1], b1[2], b1[3]};
            acc = __builtin_amdgcn_mfma_f32_16x16x32_bf16(A, B, acc, 0, 0, 0); }
        st = st * decay + acc;
        LDS_WAIT(); asm volatile("" ::: "memory");
    }
}

__device__ __forceinline__ void ret_unit(LAS uchar* lds, int b, int h, int n, const bf16* QR, const bf16* KR, bf16* VRY, const bf16* RT, const bf16* RG, const float* ret_norm, float lgf2, float lgb2) {
    int tid = threadIdx.x; asm volatile("" : "+v"(tid));
    const int lane = tid & 63, wid = __builtin_amdgcn_readfirstlane(tid >> 6), ib = wid & 3, eh = wid >> 2, r32 = lane & 31, hi = lane >> 5;
    const size_t tok0 = (size_t)b * SEQ + n * 128;
    { u32x4 tk[2], tv[4];
#pragma unroll
      for (int i = 0; i < 2; ++i) { const int pc = tid + 512 * i, row = pc >> 3, ch = pc & 7; tk[i] = *(const u32x4*)(KR + (tok0 + row) * 256 + 64 * h + 8 * ch); }
#pragma unroll
      for (int i = 0; i < 4; ++i) { const int pc = tid + 512 * i, row = pc >> 4, ch = pc & 15; tv[i] = *(const u32x4*)(VRY + (tok0 + row) * 512 + 128 * h + 8 * ch); }
#pragma unroll
      for (int i = 0; i < 2; ++i) { const int pc = tid + 512 * i, row = pc >> 3, ch = pc & 7; *(LAS u32x4*)(lds + koff(row, ch)) = tk[i]; }
#pragma unroll
      for (int i = 0; i < 4; ++i) { const int pc = tid + 512 * i, row = pc >> 4, ch = pc & 15; *(LAS u32x4*)(lds + 16384 + voff(row, ch)) = tv[i]; } }
    bf16x8 qf[4];
    { const bf16* qp = QR + (tok0 + 32 * ib + r32) * 256 + 64 * h + 8 * hi;
#pragma unroll
      for (int s = 0; s < 4; ++s) qf[s] = *(const bf16x8*)(qp + 16 * s); }
    __syncthreads();
    f32x16 y[2];
#pragma unroll
    for (int cc = 0; cc < 2; ++cc) {
        const bf16* rF = RT + ((((size_t)(b * 4 + h) * 2 + 0) * 16 + n) * 128 + 64 * eh + 32 * cc + r32) * 64 + 8 * hi;
        const bf16* rB = rF + (size_t)16 * 128 * 64;
        f32x16 af, ab;
#pragma unroll
        for (int r = 0; r < 16; ++r) { af[r] = 0.f; ab[r] = 0.f; }
#pragma unroll
        for (int s = 0; s < 4; ++s) { const bf16x8 bf_ = *(const bf16x8*)(rF + 16 * s), bb_ = *(const bf16x8*)(rB + 16 * s); af = MFMA32(qf[s], bf_, af); ab = MFMA32(qf[s], bb_, ab); }
#pragma unroll
        for (int r = 0; r < 16; ++r) { const int i = 32 * ib + crow(r, hi); y[cc][r] = ex2((float)(i + 1) * lgf2) * af[r] + ex2((float)(128 - i) * lgb2) * ab[r]; }
    }
    LAS const uchar* vb = lds + 16384;
#pragma unroll
    for (int jb = 0; jb < 4; ++jb) {
        f32x16 st;
#pragma unroll
        for (int r = 0; r < 16; ++r) st[r] = 0.f;
#pragma unroll
        for (int s = 0; s < 4; ++s) { const bf16x8 kf = *(LAS const bf16x8*)(lds + koff(32 * jb + r32, 2 * s + hi)); st = MFMA32(kf, qf[s], st); }
#pragma unroll
        for (int r = 0; r < 16; ++r) { const int df = (32 * ib + r32) - (32 * jb + crow(r, hi));
            const float fac = df > 0 ? ex2((float)df * lgf2) : (df < 0 ? ex2((float)(-df) * lgb2) : 2.0f); st[r] *= fac; }
        const bf16x8 pw0 = pack8f(st, 0), pw1 = pack8f(st, 8);
#pragma unroll
        for (int cc = 0; cc < 2; ++cc) { y[cc] = MFMA32(pw0, vfrag(vb, 2 * jb, 2 * eh + cc, lane), y[cc]); y[cc] = MFMA32(pw1, vfrag(vb, 2 * jb + 1, 2 * eh + cc, lane), y[cc]); }
    }
    float ssq[16];
#pragma unroll
    for (int r = 0; r < 16; ++r) { float v = y[0][r] * y[0][r] + y[1][r] * y[1][r];
#pragma unroll
        for (int x = 1; x < 32; x <<= 1) v += __shfl_xor(v, x);
        ssq[r] = v; }
    LAS float* sbuf = (LAS float*)(lds + 49152);
    if (r32 == 0) {
#pragma unroll
        for (int r = 0; r < 16; ++r) sbuf[wid * 32 + crow(r, hi)] = ssq[r]; }
    __syncthreads();
#pragma unroll
    for (int r = 0; r < 16; ++r) ssq[r] = __builtin_amdgcn_rsqf((ssq[r] + sbuf[(wid ^ 4) * 32 + crow(r, hi)]) * (1.f / 128.f) + 1e-6f);
#pragma unroll
    for (int cc = 0; cc < 2; ++cc) { const int e = 64 * eh + 32 * cc + r32; const float gn = ret_norm[e];
#pragma unroll
        for (int r = 0; r < 16; ++r) { const size_t off = (tok0 + 32 * ib + crow(r, hi)) * 512 + 128 * h + e; VRY[off] = f2bf(y[cc][r] * ssq[r] * gn * bf2f(RG[off])); } }
    __syncthreads();
}
#ifndef MK_N_LAUNCHES
#define MK_N_LAUNCHES 1
#endif
constexpr int N_PHASES = 12;
__global__ void __launch_bounds__(NWAVES * 64, 2) mk_fwd(Args args) {
    extern __shared__ __attribute__((aligned(16))) unsigned char lds_raw[];
    LAS uchar* lds = (LAS uchar*)lds_raw;
    cg::grid_group grid = cg::this_grid();
    const int tid = threadIdx.x, lane = tid & 63, wave = __builtin_amdgcn_readfirstlane(tid >> 6);
    const int G = gridDim.x, bx = blockIdx.x, vcu = (G % 8 == 0) ? (bx % 8) * (G / 8) + bx / 8 : bx;
    const int gw = vcu * NWAVES + wave, NGW = G * NWAVES;
    uchar* ws = args.ws;
#define x (args.in[0])
#define cvec (args.in[1])
#define positions ((const int*)args.in[2])
#define w_ada (args.in[3])
#define b_ada (args.in[4])
#define out (args.out)
#define mod ((float*)(ws + WS_MOD))
#define W13A ((bf16*)(ws + WS_W13A))
#define W2A ((bf16*)(ws + WS_W2A))
#define WIN ((bf16*)(ws + WS_WIN))
#define WA ((bf16*)(ws + WS_WA))
#define WR ((bf16*)(ws + WS_WR))
#define WO ((bf16*)(ws + WS_WO))
#define W13B ((bf16*)(ws + WS_W13B))
#define W2B ((bf16*)(ws + WS_W2B))
#define cosA ((float*)(ws + WS_TAB))
#define sinA ((float*)(ws + WS_TAB + 2 * MiB))
#define cosR ((float*)(ws + WS_TAB + 4 * MiB))
#define sinR ((float*)(ws + WS_TAB + 6 * MiB))
#define H ((bf16*)(ws + WS_H))
#define RT ((bf16*)(ws + WS_H))
#define U ((bf16*)(ws + WS_Z))
#define QA ((bf16*)(ws + WS_QA))
#define KA ((bf16*)(ws + WS_KA))
#define VA ((bf16*)(ws + WS_VA))
#define QR ((bf16*)(ws + WS_QR))
#define KR ((bf16*)(ws + WS_KR))
#define VR ((bf16*)(ws + WS_VR))
#define RG ((bf16*)(ws + WS_RG))
#define GA ((bf16*)(ws + WS_GA))
#define GR ((bf16*)(ws + WS_GR))
#define T ((bf16*)(ws + WS_T))
    const int lo = args.ph_lo, hi_ph = args.ph_hi;
#ifndef PHMASK
#define PHMASK 0xffff
#endif
#define IN(k) (((PHMASK >> (k)) & 1) && lo <= (k) && (k) < hi_ph)
#define SEAM(k) do { if (IN(k) && IN((k) + 1)) grid.sync(); } while (0)

    if (IN(0)) {
        LAS float* scr = (LAS float*)(lds + wave * 16384);
        constexpr int I13 = 16 * 176, I2 = 44 * 32, IIN = 16 * 160, IBR = 8 * 32, IO = 16 * 32;
        constexpr int NITEMS = 2 * I13 + 2 * I2 + IIN + 2 * IBR + IO;
        for (int it = gw; it < NITEMS; it += NGW) {
            int r = it;
            if (r < I13) { tr_w13(args.in[6], args.in[7], W13A, r, scr, lane); continue; } r -= I13;
            if (r < I2) { tr_plain(args.in[8], FF, D, W2A, r, scr, lane); continue; } r -= I2;
            if (r < IIN) { tr_win(args.in[10], WIN, r, scr, lane); continue; } r -= IIN;
            if (r < IBR) { tr_plain(args.in[22], 512, D, WA, r, scr, lane); continue; } r -= IBR;
            if (r < IBR) { tr_plain(args.in[23], 512, D, WR, r, scr, lane); continue; } r -= IBR;
            if (r < IO) { tr_plain(args.in[24], D, D, WO, r, scr, lane); continue; } r -= IO;
            if (r < I13) { tr_w13(args.in[26], args.in[27], W13B, r, scr, lane); continue; } r -= I13;
            tr_plain(args.in[28], FF, D, W2B, r, scr, lane);
        }
        for (int task = gw; task < 144 * 16; task += NGW) {
            const int cgp = task % 144, ks = task / 144, n = 64 * cgp + lane;
            float sv[8], a[8];
#pragma unroll
            for (int b = 0; b < 8; ++b) { sv[b] = pg8::silu(cvec[b * D + 64 * ks + lane]); a[b] = 0.f; }
#pragma unroll 8
            for (int kk = 0; kk < 64; ++kk) { const float w = w_ada[(size_t)(64 * ks + kk) * NMOD + n];
#pragma unroll
                for (int b = 0; b < 8; ++b) a[b] += __uint_as_float(__builtin_amdgcn_readlane(__float_as_uint(sv[b]), kk)) * w; }
            const float bias = ks == 0 ? b_ada[n] : 0.f;
#pragma unroll
            for (int b = 0; b < 8; ++b) atomicAdd(mod + (size_t)b * NMOD + n, a[b] + bias);
        }
        for (int idx = (vcu * NWAVES * 64 + tid); idx < M * 32; idx += G * NWAVES * 64) {
            const int tok = idx >> 5, i = idx & 31; const double pos = (double)positions[tok];
            const double TWO_PI_HI = 6.283185307179586, TWO_PI_LO = 2.4492935982947064e-16, INV2PI = 0.15915494309189535;
            { const double inv = exp2(-13.287712379549449 * (double)i / 32.0); const double a = pos * inv, k = rint(a * INV2PI); double r = fma(-k, TWO_PI_HI, a); r = fma(-k, TWO_PI_LO, r); const float rf = (float)r; cosA[idx] = cosf(rf); sinA[idx] = sinf(rf); }
            { const double inv = exp2(-13.287712379549449 * (double)i / 31.0); const double a = pos * inv, k = rint(a * INV2PI); double r = fma(-k, TWO_PI_HI, a); r = fma(-k, TWO_PI_LO, r); const float rf = (float)r; cosR[idx] = cosf(rf); sinR[idx] = sinf(rf); }
        }
    }
    SEAM(0);
    if (IN(1)) norm_phase(x, args.in[5], mod + 0 * D, mod + 1 * D, H, gw, NGW, lane);
    SEAM(1);
    if (IN(2)) { pg8::Gemm g{H, W13A, M, 2 * FF, D}; pg8::StaticOrder S; S.init(M, 2 * FF, G, bx); pg8::EpiUp E{U, FF};
        pg8::gemm_phase<pg8::EpiUp, pg8::StaticOrder, true, true>(lds, g, S, E); }
    SEAM(2);
    if (IN(3)) { pg8::Gemm g{U, W2A, M, D, FF}; pg8::StaticOrder S; S.init(M, D, G, bx); pg8::EpiRes E{x, out, mod + 2 * D, 0.5f};
        pg8::gemm_phase<pg8::EpiRes, pg8::StaticOrder, true, true>(lds, g, S, E); }
    SEAM(3);
    if (IN(4)) norm_phase(out, args.in[9], mod + 3 * D, mod + 4 * D, H, gw, NGW, lane);
    SEAM(4);
    if (IN(5)) { pg8::Gemm g{H, WIN, M, NIN, D}; pg8::StaticOrder S; S.init(M, NIN, G, bx);
        pg8::EpiIn E{QA, KA, VA, QR, KR, VR, RG, GA, GR, args.in[12], args.in[13], args.in[11], cosA, sinA, cosR, sinR, QSCALE};
        pg8::gemm_phase<pg8::EpiIn, pg8::StaticOrder, true, true>(lds, g, S, E); }
    SEAM(5);
    if (IN(6)) { for (int task = gw; task < 2048; task += NGW) ret_state_task(lds + wave * 8192, task, KR, VR, RT, args.in[19], args.in[20], lane); }
    SEAM(6);
    if (IN(7)) {
        const float l1 = wave_sum(args.in[14][lane] * args.in[15][lane]), l2 = wave_sum(args.in[16][lane] * args.in[17][lane]);
        const float lam = expf(l1) - expf(l2) + 0.2f;
        float mq = fabsf(args.in[12][lane]), mk = fabsf(args.in[13][lane]);
#pragma unroll
        for (int o = 1; o < 64; o <<= 1) { mq = fmaxf(mq, __shfl_xor(mq, o)); mk = fmaxf(mk, __shfl_xor(mk, o)); }
        const float negC = -(8.0f * LOG2E * mq * mk);
#ifndef NO_ATT
        for (int u = vcu; u < 512; u += G) attn_unit(lds, u >> 6, (u >> 4) & 3, u & 15, QA, KA, VA, QA, negC, lam, args.in[18]);
#endif
#ifndef NO_RET
        for (int u = vcu; u < 512; u += G) { const int b = u >> 6, h = (u >> 4) & 3;
            const float lgf2 = -log1pf(expf(-args.in[19][h])) * LOG2E, lgb2 = -log1pf(expf(-args.in[20][h])) * LOG2E;
            ret_unit(lds, b, h, u & 15, QR, KR, VR, RT, RG, args.in[21], lgf2, lgb2); }
#endif
    }
    SEAM(7);
    if (IN(8)) {
        { pg8::Gemm g{QA, WA, M, D, 512}; pg8::StaticOrder S; S.init(M, D, G, bx); pg8::EpiBr<0> E{T, GA}; pg8::gemm_phase<pg8::EpiBr<0>, pg8::StaticOrder, true, true>(lds, g, S, E); }
        { pg8::Gemm g{VR, WR, M, D, 512}; pg8::StaticOrder S; S.init(M, D, G, bx); pg8::EpiBr<1> E{T, GR}; pg8::gemm_phase<pg8::EpiBr<1>, pg8::StaticOrder, true, true>(lds, g, S, E); }
    }
    SEAM(8);
    if (IN(9)) { pg8::Gemm g{T, WO, M, D, D}; pg8::StaticOrder S; S.init(M, D, G, bx); pg8::EpiRes E{out, out, mod + 5 * D, 1.0f};
        pg8::gemm_phase<pg8::EpiRes, pg8::StaticOrder, true, true>(lds, g, S, E); }
    SEAM(9);
    if (IN(10)) norm_phase(out, args.in[25], mod + 6 * D, mod + 7 * D, H, gw, NGW, lane);
    SEAM(10);
    if (IN(11)) { pg8::Gemm g{H, W13B, M, 2 * FF, D}; pg8::StaticOrder S; S.init(M, 2 * FF, G, bx); pg8::EpiUp E{U, FF};
        pg8::gemm_phase<pg8::EpiUp, pg8::StaticOrder, true, true>(lds, g, S, E); }
    SEAM(11);
    if (IN(12)) { pg8::Gemm g{U, W2B, M, D, FF}; pg8::StaticOrder S; S.init(M, D, G, bx); pg8::EpiRes E{out, out, mod + 8 * D, 0.5f};
        pg8::gemm_phase<pg8::EpiRes, pg8::StaticOrder, true, true>(lds, g, S, E); }
#undef IN
#undef SEAM
}

#undef x
#undef cvec
#undef positions
#undef w_ada
#undef b_ada
#undef out
#undef mod
#undef W13A
#undef W2A
#undef WIN
#undef WA
#undef WR
#undef WO
#undef W13B
#undef W2B
#undef cosA
#undef sinA
#undef cosR
#undef sinR
#undef H
#undef RT
#undef U
#undef QA
#undef KA
#undef VA
#undef QR
#undef KR
#undef VR
#undef RG
#undef GA
#undef GR
#undef T
extern "C" void kernel_launch(void* const* d_in, const int* in_sizes, int n_in, void* d_out, int out_size, void* d_ws, size_t ws_size, hipStream_t stream) {
    static int grid = 0;
    if (grid == 0) {
        if (n_in != 29 || out_size != M * D || ws_size < WS_END) { fprintf(stderr, "kernel_launch: unexpected shapes (n_in %d out %d ws %zu)\n", n_in, out_size, ws_size); grid = -1; return; }
        int dev = 0, cus = 0, per_cu = 0;
        (void)hipGetDevice(&dev); (void)hipDeviceGetAttribute(&cus, hipDeviceAttributeMultiprocessorCount, dev);
        if (hipFuncSetAttribute((const void*)mk_fwd, hipFuncAttributeMaxDynamicSharedMemorySize, LDS_BYTES) != hipSuccess) { fprintf(stderr, "kernel_launch: hipFuncSetAttribute failed\n"); grid = -1; return; }
        if (hipOccupancyMaxActiveBlocksPerMultiprocessor(&per_cu, (const void*)mk_fwd, NWAVES * 64, LDS_BYTES) != hipSuccess || per_cu < 1) { fprintf(stderr, "kernel_launch: occupancy query says %d\n", per_cu); per_cu = 1; }
        (void)hipGetLastError();
        grid = cus * 1;
        if (grid <= 0) grid = 256;
    }
    if (grid < 0) return;
    (void)hipMemsetAsync((char*)d_ws + WS_CTL, 0, CTL_ZERO_BYTES, stream);
    Args a{};
    for (int i = 0; i < 29; ++i) a.in[i] = (const float*)d_in[i];
    a.out = (float*)d_out; a.ws = (unsigned char*)d_ws;
#if MK_N_LAUNCHES == 1
    a.ph_lo = 0; a.ph_hi = N_PHASES + 1;
    void* kargs[] = {&a};
    hipError_t e = hipLaunchCooperativeKernel((const void*)mk_fwd, dim3(grid), dim3(NWAVES * 64), kargs, LDS_BYTES, stream);
    if (e != hipSuccess) fprintf(stderr, "kernel_launch: cooperative launch failed: %s (grid %d)\n", hipGetErrorString(e), grid);
#else
    for (int p = 0; p <= N_PHASES; ++p) { a.ph_lo = p; a.ph_hi = p + 1; hipLaunchKernelGGL(mk_fwd, dim3(grid), dim3(NWAVES * 64), LDS_BYTES, stream, a); }
#endif
}
```

```cpp
#include <hip/hip_runtime.h>
#include <hip/hip_cooperative_groups.h>
#include <cstdio>
#include <cstdint>
#include <cmath>
namespace cg = cooperative_groups;


namespace pg8 {
#define PG8_LAS __attribute__((address_space(3)))
typedef unsigned short bf16_t;
typedef short bf16x8 __attribute__((ext_vector_type(8)));
typedef float f32x4 __attribute__((ext_vector_type(4)));
typedef unsigned u32x4 __attribute__((ext_vector_type(4)));
constexpr int BM = 256, BK = 64, HALF = 128, HTB = HALF * BK * 2  , STAGE_BYTES = 8 * HTB, NXCD = 8, WGM = 8;

__host__ __device__ __forceinline__ int lds_byte(int r, int c) { const int st = (r >> 4) * 2 + (c >> 5), rr = r & 15, cc = c & 31, ob = rr * 64 + cc * 2; return st * 1024 + (ob ^ (((ob >> 9) & 1) << 5)); }
__host__ __device__ __forceinline__ void stage_rc(int b, int& R, int& C) { const int st = b / 1024, sb = b % 1024, swz = sb ^ (((sb >> 9) & 1) << 5); R = (st >> 1) * 16 + swz / 64; C = (st & 1) * 32 + (swz % 64) / 2; }
__host__ __device__ __forceinline__ int perm32(int rho) { const int n = rho >> 4, i = rho & 15; return 8 * (i >> 2) + 4 * n + (i & 3); }

struct Unit { int pm, pn; };
struct Gemm { const bf16_t* A; const bf16_t* Bt; int M, N, K; };

struct StaticOrder {
    int nM, nN, nwg, G, c;
    __host__ __device__ void init(int M, int N, int G_, int c_) { nM = M / BM; nN = N / BM; nwg = nM * nN; G = G_; c = c_; }
    __host__ __device__ bool next(int i, Unit& u) const {
        const long L = (long)i * G + c; if (L >= nwg) return false;
        int wgid = (int)L; { const int q = nwg / NXCD, r = nwg % NXCD, xcd = wgid % NXCD, off = wgid / NXCD; wgid = (xcd < r ? xcd * (q + 1) : r * (q + 1) + (xcd - r) * q) + off; }
        const int nig = WGM * nN, gid = wgid / nig, fm = gid * WGM, gsz = (nM - fm) < WGM ? (nM - fm) : WGM;
        u.pm = fm + ((wgid % nig) % gsz); u.pn = (wgid % nig) / gsz; return true;
    }
    __device__ __forceinline__ void a_ready(const Unit&) const {}
    __device__ __forceinline__ void done(const Unit&) const {}
};

__device__ __forceinline__ unsigned cvt_pk_bf16(float lo, float hi) { unsigned r; asm volatile("v_cvt_pk_bf16_f32 %0, %1, %2" : "=v"(r) : "v"(lo), "v"(hi)); return r; }
typedef float f32x2 __attribute__((ext_vector_type(2)));
__device__ __forceinline__ float bflo(unsigned w) { return __uint_as_float(w << 16); }
__device__ __forceinline__ float bfhi(unsigned w) { return __uint_as_float(w & 0xffff0000u); }
__device__ __forceinline__ float sigm(float v) { return __builtin_amdgcn_rcpf(1.f + __builtin_amdgcn_exp2f(-1.4426950408889634f * v)); }
__device__ __forceinline__ float silu(float v) { return v * sigm(v); }
__device__ __forceinline__ u32x4 pack8(const float (&o)[8]) { u32x4 w; w.x = cvt_pk_bf16(o[0], o[1]); w.y = cvt_pk_bf16(o[2], o[3]); w.z = cvt_pk_bf16(o[4], o[5]); w.w = cvt_pk_bf16(o[6], o[7]); return w; }

struct EpiUp {
    static constexpr bool PERM = true, AFTER_DRAIN = false;
    bf16_t* U; int ldu;
    __device__ __forceinline__ void operator()(const f32x4 (&acc)[2][2][4][2], const Unit& u, int wr, int wc, int fr, int fq) const {
        const int row0 = u.pm * BM + wr * 64 + fr, col0 = u.pn * 128 + wc * 32 + 8 * fq;
#pragma unroll
        for (int ai = 0; ai < 2; ++ai)
#pragma unroll
            for (int m = 0; m < 4; ++m) {
                float o[8];
#pragma unroll
                for (int n = 0; n < 2; ++n)
#pragma unroll
                    for (int e = 0; e < 4; ++e) o[4 * n + e] = silu(acc[ai][0][m][n][e]) * acc[ai][1][m][n][e];
                *(u32x4*)(U + (size_t)(row0 + ai * HALF + m * 16) * ldu + col0) = pack8(o);
            }
    }
};
struct EpiRes {
    static constexpr bool PERM = false, AFTER_DRAIN = false;
    const float* xin; float* xout; const float* gate; float scale;
    __device__ __forceinline__ void operator()(const f32x4 (&acc)[2][2][4][2], const Unit& u, int wr, int wc, int fr, int fq) const {
        const int b = u.pm >> 3, col0 = u.pn * BM + wc * 32 + 4 * fq;
        f32x4 gv[2][2];
#pragma unroll
        for (int bj = 0; bj < 2; ++bj)
#pragma unroll
            for (int n = 0; n < 2; ++n) gv[bj][n] = *(const f32x4*)(gate + (size_t)b * 9216 + col0 + bj * HALF + n * 16) * scale;
#pragma unroll
        for (int ai = 0; ai < 2; ++ai)
#pragma unroll
            for (int m = 0; m < 4; ++m) { const size_t off = (size_t)(u.pm * BM + ai * HALF + wr * 64 + m * 16 + fr) * 1024 + col0;
#pragma unroll
                for (int bj = 0; bj < 2; ++bj)
#pragma unroll
                    for (int n = 0; n < 2; ++n) { const f32x4 xi = *(const f32x4*)(xin + off + bj * HALF + n * 16); *(f32x4*)(xout + off + bj * HALF + n * 16) = xi + gv[bj][n] * acc[ai][bj][m][n]; } }
    }
};
struct EpiIn {
    static constexpr bool PERM = true, AFTER_DRAIN = false;
    unsigned char* ws; const float *gq, *gk, *bmerge; float qscale;
    static constexpr size_t Mi = 1u << 20, oTAB = 50 * Mi, oZ = 90 * Mi;
    static constexpr size_t oQA = oZ, oKA = oZ + 16 * Mi, oVA = oZ + 32 * Mi, oQR = oZ + 48 * Mi, oKR = oZ + 56 * Mi, oVR = oZ + 64 * Mi, oRG = oZ + 80 * Mi, oGA = oZ + 96 * Mi, oGR = oZ + 128 * Mi;
    __device__ __forceinline__ void operator()(const f32x4 (&acc)[2][2][4][2], const Unit& u, int wr, int wc, int fr, int fq) const {
        const int pn = u.pn, row0 = u.pm * BM + wr * 64 + fr, d0 = 8 * fq;
        if (pn < 4) {
            const bool isq = pn < 2; bf16_t* dst = (bf16_t*)(ws + (isq ? oQA : oKA)); const float* cosA = (const float*)(ws + oTAB); const float* sinA = (const float*)(ws + oTAB + 2 * Mi); const float* g = isq ? gq : gk; const float osc = isq ? qscale : 1.f;
            const int hh = 4 * (pn & 1) + wc;
            float g0[8], g1[8];
#pragma unroll
            for (int e = 0; e < 8; ++e) { g0[e] = g[d0 + e]; g1[e] = g[32 + d0 + e]; }
#pragma unroll
            for (int ai = 0; ai < 2; ++ai)
#pragma unroll
                for (int m = 0; m < 4; ++m) { const int row = row0 + ai * HALF + m * 16;
                    float x0[8], x1[8], ss = 0.f;
#pragma unroll
                    for (int n = 0; n < 2; ++n)
#pragma unroll
                        for (int e = 0; e < 4; ++e) { x0[4 * n + e] = acc[ai][0][m][n][e]; x1[4 * n + e] = acc[ai][1][m][n][e]; }
#pragma unroll
                    for (int e = 0; e < 8; ++e) ss += x0[e] * x0[e] + x1[e] * x1[e];
                    ss += __shfl_xor(ss, 16); ss += __shfl_xor(ss, 32);
                    const float rstd = __builtin_amdgcn_rsqf(ss * (1.f / 64.f) + 1e-6f);
                    const f32x4 c0 = *(const f32x4*)(cosA + (size_t)row * 32 + d0), c1 = *(const f32x4*)(cosA + (size_t)row * 32 + d0 + 4);
                    const f32x4 s0 = *(const f32x4*)(sinA + (size_t)row * 32 + d0), s1 = *(const f32x4*)(sinA + (size_t)row * 32 + d0 + 4);
                    float o0[8], o1[8];
#pragma unroll
                    for (int e = 0; e < 8; ++e) { const float c = e < 4 ? c0[e & 3] : c1[e & 3], s = e < 4 ? s0[e & 3] : s1[e & 3];
                        const float a = x0[e] * rstd * g0[e], bb = x1[e] * rstd * g1[e]; o0[e] = (a * c - bb * s) * osc; o1[e] = (bb * c + a * s) * osc; }
                    bf16_t* p = dst + (size_t)row * 512 + 64 * hh + d0;
                    *(u32x4*)p = pack8(o0); *(u32x4*)(p + 32) = pack8(o1); }
        } else if (pn == 6 || pn == 7) {
            bf16_t* dst = (bf16_t*)(ws + (pn == 6 ? oQR : oKR)); const float* cosR = (const float*)(ws + oTAB + 4 * Mi); const float* sinR = (const float*)(ws + oTAB + 6 * Mi); const float osc = pn == 6 ? 1.f : 0.125f;
#pragma unroll
            for (int ai = 0; ai < 2; ++ai)
#pragma unroll
                for (int m = 0; m < 4; ++m) { const int row = row0 + ai * HALF + m * 16;
                    const f32x4 c0 = *(const f32x4*)(cosR + (size_t)row * 32 + d0), c1 = *(const f32x4*)(cosR + (size_t)row * 32 + d0 + 4);
                    const f32x4 s0 = *(const f32x4*)(sinR + (size_t)row * 32 + d0), s1 = *(const f32x4*)(sinR + (size_t)row * 32 + d0 + 4);
                    float o0[8], o1[8];
#pragma unroll
                    for (int n = 0; n < 2; ++n)
#pragma unroll
                        for (int e = 0; e < 4; ++e) { const float c = n == 0 ? c0[e] : c1[e], s = n == 0 ? s0[e] : s1[e]; const float xe = acc[ai][0][m][n][e], xo = acc[ai][1][m][n][e];
                            o0[4 * n + e] = (xe * c - xo * s) * osc; o1[4 * n + e] = (xo * c + xe * s) * osc; }
                    bf16_t* p = dst + (size_t)row * 256 + 64 * wc + d0;
                    *(u32x4*)p = pack8(o0); *(u32x4*)(p + 32) = pack8(o1); }
        } else {
            bf16_t* dst; int ld, cb, op; const float* bias = nullptr;
            if (pn < 6) { dst = (bf16_t*)(ws + oVA); ld = 512; cb = 256 * (pn - 4); op = 0; }
            else if (pn < 10) { dst = (bf16_t*)(ws + oVR); ld = 512; cb = 256 * (pn - 8); op = 0; }
            else if (pn < 12) { dst = (bf16_t*)(ws + oRG); ld = 512; cb = 256 * (pn - 10); op = 1; }
            else if (pn < 16) { dst = (bf16_t*)(ws + oGA); ld = 1024; cb = 256 * (pn - 12); op = 2; bias = bmerge; }
            else { dst = (bf16_t*)(ws + oGR); ld = 1024; cb = 256 * (pn - 16); op = 2; bias = bmerge + 1024; }
#pragma unroll
            for (int bj = 0; bj < 2; ++bj) { const int col = cb + bj * HALF + wc * 32 + d0;
                f32x4 b0 = (f32x4){0.f, 0.f, 0.f, 0.f}, b1 = b0; if (op == 2) { b0 = *(const f32x4*)(bias + col); b1 = *(const f32x4*)(bias + col + 4); }
#pragma unroll
                for (int ai = 0; ai < 2; ++ai)
#pragma unroll
                    for (int m = 0; m < 4; ++m) { const int row = row0 + ai * HALF + m * 16; float o[8];
#pragma unroll
                        for (int e = 0; e < 4; ++e) { float v0 = acc[ai][bj][m][0][e] + b0[e], v1 = acc[ai][bj][m][1][e] + b1[e];
                            if (op == 1) { v0 = silu(v0); v1 = silu(v1); } else if (op == 2) { v0 = sigm(v0); v1 = sigm(v1); }
                            o[e] = v0; o[4 + e] = v1; }
                        *(u32x4*)(dst + (size_t)row * ld + col) = pack8(o); } }
        }
    }
};
template <int MODE> struct EpiBr {
    static constexpr bool PERM = true, AFTER_DRAIN = false;
    bf16_t* T; const bf16_t* G;
    __device__ __forceinline__ void operator()(const f32x4 (&acc)[2][2][4][2], const Unit& u, int wr, int wc, int fr, int fq) const {
        const int row0 = u.pm * BM + wr * 64 + fr, col0 = u.pn * BM + wc * 32 + 8 * fq;
#pragma unroll
        for (int ai = 0; ai < 2; ++ai)
#pragma unroll
            for (int m = 0; m < 4; ++m)
#pragma unroll
                for (int bj = 0; bj < 2; ++bj) { const size_t off = (size_t)(row0 + ai * HALF + m * 16) * 1024 + col0 + bj * HALF;
                    const u32x4 gw = *(const u32x4*)(G + off); u32x4 tw = (u32x4){0u, 0u, 0u, 0u}; if (MODE == 1) tw = *(const u32x4*)(T + off);
                    const f32x4 a0 = acc[ai][bj][m][0], a1 = acc[ai][bj][m][1]; float o[8];
                    o[0] = bflo(gw.x) * a0[0]; o[1] = bfhi(gw.x) * a0[1]; o[2] = bflo(gw.y) * a0[2]; o[3] = bfhi(gw.y) * a0[3];
                    o[4] = bflo(gw.z) * a1[0]; o[5] = bfhi(gw.z) * a1[1]; o[6] = bflo(gw.w) * a1[2]; o[7] = bfhi(gw.w) * a1[3];
                    if (MODE == 1) { o[0] += bflo(tw.x); o[1] += bfhi(tw.x); o[2] += bflo(tw.y); o[3] += bfhi(tw.y); o[4] += bflo(tw.z); o[5] += bfhi(tw.z); o[6] += bflo(tw.w); o[7] += bfhi(tw.w); }
                    *(u32x4*)(T + off) = pack8(o); }
    }
};
template <class Epi, class Sched, bool ALIGN_EPI = false, bool SP2 = false>
__device__ __forceinline__ void gemm_phase(PG8_LAS unsigned char* lds, const Gemm g, const Sched& S, const Epi& E) {
    const int tid = threadIdx.x, wid = __builtin_amdgcn_readfirstlane(tid >> 6), lane = tid & 63, wr = wid >> 2, wc = wid & 3, fr = lane & 15, fq = lane >> 4;
    const int K = g.K, nt = K / BK;
    unsigned voffA[2], voffB[2];
#pragma unroll
    for (int i = 0; i < 2; ++i) { int R, C; stage_rc(tid * 16 + i * 8192, R, C); const int Rb = Epi::PERM ? ((R & ~31) + perm32(R & 31)) : R;
        voffA[i] = (unsigned)(R * K + C) * 2u; voffB[i] = (unsigned)(Rb * K + C) * 2u; }
    const size_t kstep = (size_t)(BK * 2);
    const size_t hstep = (size_t)HALF * K * 2;
    const size_t tstep = 2 * hstep;
    const unsigned ldsw = (unsigned)wid * 1024u;
    const int aoff = lds_byte(wr * 64 + fr, fq * 8), boff = lds_byte(wc * 32 + fr, fq * 8);
#define PG8_SA(b, h) (((b) * 2 + (h)) * HTB)
#define PG8_SB(b, h) ((4 + (b) * 2 + (h)) * HTB)
#define PG8_STAGE(bufoff, gbase, voff) do { _Pragma("unroll") for (int _i = 0; _i < 2; ++_i) \
        __builtin_amdgcn_global_load_lds((const unsigned*)((const char*)(gbase) + (voff)[_i]), (PG8_LAS unsigned*)(lds + (bufoff) + ldsw + _i * 8192), 16, 0, 0); } while (0)
#define PG8_LDA(dst, b, h) do { _Pragma("unroll") for (int m = 0; m < 4; ++m) _Pragma("unroll") for (int k = 0; k < 2; ++k) dst[m][k] = *(const PG8_LAS bf16x8*)(lds + PG8_SA(b, h) + aoff + m * 2048 + k * 1024); } while (0)
#define PG8_LDB(dst, b, h) do { _Pragma("unroll") for (int n = 0; n < 2; ++n) _Pragma("unroll") for (int k = 0; k < 2; ++k) dst[n][k] = *(const PG8_LAS bf16x8*)(lds + PG8_SB(b, h) + boff + n * 2048 + k * 1024); } while (0)
#define PG8_MMA(ai, bj, At, Bt) do { __builtin_amdgcn_s_setprio(1); _Pragma("unroll") for (int m = 0; m < 4; ++m) _Pragma("unroll") for (int n = 0; n < 2; ++n) _Pragma("unroll") for (int k = 0; k < 2; ++k) \
        acc[ai][bj][m][n] = __builtin_amdgcn_mfma_f32_16x16x32_bf16(Bt[n][k], At[m][k], acc[ai][bj][m][n], 0, 0, 0); __builtin_amdgcn_s_setprio(0); } while (0)
#define PG8_WAIT_V(n) asm volatile("s_waitcnt vmcnt(" #n ")" ::: "memory")
#define PG8_WAIT_L(n) asm volatile("s_waitcnt lgkmcnt(" #n ")" ::: "memory")
#define PG8_BAR __builtin_amdgcn_s_barrier()
#define PG8_SCHED __builtin_amdgcn_sched_barrier(0)
    Unit cur, nxt; int ui = 0;
    if (!S.next(0, cur)) return;
    f32x4 acc[2][2][4][2];
#pragma unroll
    for (int a = 0; a < 2; ++a)
#pragma unroll
        for (int b = 0; b < 2; ++b)
#pragma unroll
            for (int m = 0; m < 4; ++m)
#pragma unroll
                for (int n = 0; n < 2; ++n) acc[a][b][m][n] = (f32x4){0.f, 0.f, 0.f, 0.f};
    bf16x8 At[4][2], B0[2][2], B1[2][2];
    const char* cA = (const char*)g.A + (size_t)cur.pm * tstep; const char* cB = (const char*)g.Bt + (size_t)cur.pn * tstep;
    S.a_ready(cur);
    if constexpr (SP2) {
        PG8_STAGE(PG8_SB(0, 0), cB, voffB); PG8_STAGE(PG8_SB(0, 1), cB + hstep, voffB); PG8_STAGE(PG8_SA(0, 0), cA, voffA); PG8_STAGE(PG8_SA(0, 1), cA + hstep, voffA);
        if (wr == 1) PG8_BAR;
        PG8_WAIT_V(2); PG8_BAR;
        PG8_STAGE(PG8_SB(1, 0), cB + kstep, voffB); PG8_STAGE(PG8_SA(1, 0), cA + kstep, voffA); PG8_STAGE(PG8_SB(1, 1), cB + hstep + kstep, voffB);
        PG8_WAIT_V(6); PG8_BAR;
    } else {
        PG8_STAGE(PG8_SB(0, 0), cB, voffB); PG8_STAGE(PG8_SA(0, 0), cA, voffA); PG8_STAGE(PG8_SB(0, 1), cB + hstep, voffB); PG8_STAGE(PG8_SA(0, 1), cA + hstep, voffA);
        if (wr == 1) PG8_BAR;
        PG8_WAIT_V(4); PG8_BAR;
        PG8_STAGE(PG8_SB(1, 0), cB + kstep, voffB); PG8_STAGE(PG8_SA(1, 0), cA + kstep, voffA); PG8_STAGE(PG8_SB(1, 1), cB + hstep + kstep, voffB);
        PG8_WAIT_V(6); PG8_BAR;
    }
    for (;;) {
        const bool has_next = S.next(ui + 1, nxt);
        const char* nA = has_next ? (const char*)g.A + (size_t)nxt.pm * tstep : cA; const char* nB = has_next ? (const char*)g.Bt + (size_t)nxt.pn * tstep : cB;
        for (int t = 0; t < nt; t += 2) {
            const bool last = (t == nt - 2);
            const char* a1 = cA + (size_t)(t + 1) * kstep;
            const char* a2 = last ? nA : cA + (size_t)(t + 2) * kstep; const char* b2 = last ? nB : cB + (size_t)(t + 2) * kstep;
            const char* a3 = a2 + kstep; const char* b3 = b2 + kstep;
            if (last && has_next) S.a_ready(nxt);
            if constexpr (SP2) {
            PG8_LDB(B0, 0, 0); PG8_LDB(B1, 0, 1); PG8_SCHED; PG8_LDA(At, 0, 0); PG8_STAGE(PG8_SA(1, 1), a1 + hstep, voffA);
            PG8_WAIT_V(8); PG8_WAIT_L(0); PG8_BAR; PG8_MMA(0, 0, At, B0); PG8_MMA(0, 1, At, B1); PG8_BAR; PG8_SCHED;
            PG8_LDA(At, 0, 1); PG8_STAGE(PG8_SB(0, 0), b2, voffB); PG8_STAGE(PG8_SB(0, 1), b2 + hstep, voffB); PG8_STAGE(PG8_SA(0, 0), a2, voffA);
            PG8_WAIT_V(8); PG8_WAIT_L(0); PG8_BAR; PG8_MMA(1, 0, At, B0); PG8_MMA(1, 1, At, B1); PG8_BAR; PG8_SCHED;
            PG8_LDB(B0, 1, 0); PG8_LDB(B1, 1, 1); PG8_SCHED; PG8_LDA(At, 1, 0); PG8_STAGE(PG8_SA(0, 1), a2 + hstep, voffA);
            PG8_WAIT_V(8); PG8_WAIT_L(0); PG8_BAR; PG8_MMA(0, 0, At, B0); PG8_MMA(0, 1, At, B1); PG8_BAR; PG8_SCHED;
            PG8_LDA(At, 1, 1); PG8_STAGE(PG8_SB(1, 0), b3, voffB); PG8_STAGE(PG8_SB(1, 1), b3 + hstep, voffB); PG8_STAGE(PG8_SA(1, 0), a3, voffA);
            PG8_WAIT_V(8); PG8_WAIT_L(0); PG8_BAR; PG8_MMA(1, 0, At, B0); PG8_MMA(1, 1, At, B1); PG8_BAR; PG8_SCHED;
            } else {
            PG8_LDB(B0, 0, 0); PG8_SCHED; PG8_LDA(At, 0, 0); PG8_STAGE(PG8_SA(1, 1), a1 + hstep, voffA);
            PG8_WAIT_L(8); PG8_BAR; PG8_WAIT_L(0); PG8_MMA(0, 0, At, B0); PG8_BAR; PG8_SCHED;
            PG8_LDB(B1, 0, 1); PG8_STAGE(PG8_SB(0, 0), b2, voffB);
            PG8_BAR; PG8_WAIT_L(0); PG8_MMA(0, 1, At, B1); PG8_BAR;
            PG8_LDA(At, 0, 1); PG8_STAGE(PG8_SA(0, 0), a2, voffA);
            PG8_BAR; PG8_WAIT_L(0); PG8_MMA(1, 0, At, B0); PG8_BAR; PG8_SCHED;
            PG8_STAGE(PG8_SB(0, 1), b2 + hstep, voffB);
            PG8_WAIT_V(6); PG8_BAR; PG8_MMA(1, 1, At, B1); PG8_BAR;
            PG8_LDB(B0, 1, 0); PG8_SCHED; PG8_LDA(At, 1, 0); PG8_STAGE(PG8_SA(0, 1), a2 + hstep, voffA);
            PG8_WAIT_L(8); PG8_BAR; PG8_WAIT_L(0); PG8_MMA(0, 0, At, B0); PG8_BAR; PG8_SCHED;
            PG8_LDB(B1, 1, 1); PG8_STAGE(PG8_SB(1, 0), b3, voffB);
            PG8_BAR; PG8_WAIT_L(0); PG8_MMA(0, 1, At, B1); PG8_BAR;
            PG8_LDA(At, 1, 1); PG8_STAGE(PG8_SA(1, 0), a3, voffA);
            PG8_BAR; PG8_WAIT_L(0); PG8_MMA(1, 0, At, B0); PG8_BAR; PG8_SCHED;
            PG8_STAGE(PG8_SB(1, 1), b3 + hstep, voffB);
            PG8_WAIT_V(6); PG8_BAR; PG8_MMA(1, 1, At, B1); PG8_BAR;
            }
        }
        if constexpr (ALIGN_EPI) { if (wr == 0) PG8_BAR; }
        if constexpr (!Epi::AFTER_DRAIN) { E(acc, cur, wr, wc, fr, fq); S.done(cur); }
        if (!has_next) break;
#pragma unroll
        for (int a = 0; a < 2; ++a)
#pragma unroll
            for (int b = 0; b < 2; ++b)
#pragma unroll
                for (int m = 0; m < 4; ++m)
#pragma unroll
                    for (int n = 0; n < 2; ++n) acc[a][b][m][n] = (f32x4){0.f, 0.f, 0.f, 0.f};
        cur = nxt; cA = nA; cB = nB; ++ui;
        if constexpr (ALIGN_EPI) { if (wr == 1) PG8_BAR; }
    }
    PG8_WAIT_V(0);
    if constexpr (!ALIGN_EPI) { if (wr == 0) PG8_BAR; }
    PG8_BAR;
    if constexpr (Epi::AFTER_DRAIN) { E.fused(acc, cur, wr, wc, fr, fq, lds, wid, lane); S.done(cur); }
#undef PG8_SA
#undef PG8_SB
#undef PG8_STAGE
#undef PG8_LDA
#undef PG8_LDB
#undef PG8_MMA
#undef PG8_WAIT_V
#undef PG8_WAIT_L
#undef PG8_BAR
#undef PG8_SCHED
}
}
#define LAS __attribute__((address_space(3)))
typedef unsigned short bf16;
typedef unsigned u32x4 __attribute__((ext_vector_type(4)));
typedef float f32x4 __attribute__((ext_vector_type(4)));
typedef float f32x16 __attribute__((ext_vector_type(16)));
typedef short bf16x8 __attribute__((ext_vector_type(8)));
typedef short s16x4 __attribute__((ext_vector_type(4)));
typedef unsigned char uchar;
constexpr int NWAVES = 8;
constexpr int BATCH = 8, SEQ = 2048, D = 1024, FF = 2816, NIN = 5120, M = BATCH * SEQ, NMOD = 9 * D;
constexpr float LOG2E = 1.4426950408889634f;
constexpr float QSCALE = 0.125f * LOG2E;
constexpr size_t MiB = 1u << 20;
constexpr size_t WS_CTL = 0, CTL_ZERO_BYTES = 1 * MiB, WS_MOD = 65536;
constexpr size_t WS_W13A = 2 * MiB, WS_W2A = 13 * MiB, WS_WIN = 19 * MiB, WS_WA = 29 * MiB, WS_WR = 30 * MiB, WS_WO = 31 * MiB, WS_W13B = 33 * MiB, WS_W2B = 44 * MiB;
constexpr size_t WS_TAB = 50 * MiB;
constexpr size_t WS_H = 58 * MiB;
constexpr size_t WS_Z = 90 * MiB;
constexpr size_t WS_QA = WS_Z, WS_KA = WS_Z + 16 * MiB, WS_VA = WS_Z + 32 * MiB, WS_QR = WS_Z + 48 * MiB, WS_KR = WS_Z + 56 * MiB, WS_VR = WS_Z + 64 * MiB, WS_RG = WS_Z + 80 * MiB, WS_GA = WS_Z + 96 * MiB, WS_GR = WS_Z + 128 * MiB;
constexpr size_t WS_T = WS_KA;
constexpr size_t WS_END = 250 * MiB;
constexpr int RING_BYTES = 131072, LDS_BYTES = 147456;

#define LDS_WAIT() asm volatile("s_waitcnt lgkmcnt(0)" ::: "memory")
__device__ __forceinline__ unsigned cvtpk(float lo, float hi) { unsigned r; asm volatile("v_cvt_pk_bf16_f32 %0, %1, %2" : "=v"(r) : "v"(lo), "v"(hi)); return r; }
__device__ __forceinline__ float bf2f(unsigned short v) { return __uint_as_float((unsigned)v << 16); }
__device__ __forceinline__ unsigned short f2bf(float f) { return (unsigned short)(cvtpk(f, 0.f) & 0xffffu); }
__device__ __forceinline__ float wave_sum(float v) {
#pragma unroll
    for (int o = 1; o < 64; o <<= 1) v += __shfl_xor(v, o);
    return v;
}
__device__ __forceinline__ float ex2(float v) { return __builtin_amdgcn_exp2f(v); }

struct Args { const float* in[29]; float* out; unsigned char* ws; int ph_lo, ph_hi; };

__device__ __forceinline__ void tr_item(const float* W, int Nsrc, int scol0, int cstride, int k0, bf16* WT, int Kdst, int drow0, LAS float* scr, int lane) {
#pragma unroll 8
    for (int i = 0; i < 32; ++i) { const int kk = 2 * i + (lane >> 5); scr[kk * 33 + (lane & 31)] = W[(size_t)(k0 + kk) * Nsrc + scol0 + (lane & 31) * cstride]; }
    LDS_WAIT(); asm volatile("" ::: "memory");
    const int c = lane & 7;
#pragma unroll
    for (int j = 0; j < 4; ++j) { const int n = (lane >> 3) + 8 * j; const LAS float* s = scr + (8 * c) * 33 + n;
        u32x4 o; o.x = cvtpk(s[0 * 33], s[1 * 33]); o.y = cvtpk(s[2 * 33], s[3 * 33]); o.z = cvtpk(s[4 * 33], s[5 * 33]); o.w = cvtpk(s[6 * 33], s[7 * 33]);
        *(u32x4*)(WT + (size_t)(drow0 + n) * Kdst + k0 + 8 * c) = o; }
    LDS_WAIT(); asm volatile("" ::: "memory");
}
__device__ __forceinline__ void tr_w13(const float* w1, const float* w3, bf16* WT, int it, LAS float* scr, int lane) {
    const int kb = it / 176, nb = it % 176, n0 = 32 * nb, pn = n0 >> 8, bj = (n0 >> 7) & 1, j0 = n0 & 127;
    tr_item(bj ? w3 : w1, FF, 128 * pn + j0, 1, 64 * kb, WT, D, n0, scr, lane);
}
__device__ __forceinline__ void tr_plain(const float* W, int K, int N, bf16* WT, int it, LAS float* scr, int lane) {
    const int nblk = N / 32, kb = it / nblk, nb = it % nblk;
    tr_item(W, N, 32 * nb, 1, 64 * kb, WT, K, 32 * nb, scr, lane);
}
__device__ __forceinline__ void tr_win(const float* W, bf16* WT, int it, LAS float* scr, int lane) {
    const int kb = it / 160, nb = it % 160, n0 = 32 * nb, pn = n0 >> 8, bj = (n0 >> 7) & 1, wc = (n0 >> 5) & 3;
    int scol0 = n0, cs = 1;
    if (pn < 4) scol0 = 256 * pn + 64 * wc + 32 * bj;
    else if (pn == 6 || pn == 7) { scol0 = 256 * pn + 64 * wc + bj; cs = 2; }
    tr_item(W, NIN, scol0, cs, 64 * kb, WT, D, n0, scr, lane);
}
__device__ __forceinline__ void norm_phase(const float* xin, const float* g, const float* sh, const float* sc, bf16* H, int gw, int NGW, int lane) {
    for (int rb = gw; rb < M / 8; rb += NGW) {
        const int b = rb >> 8;
        f32x4 A[4], Bv[4];
#pragma unroll
        for (int j = 0; j < 4; ++j) { const int col = 4 * lane + 256 * j; const f32x4 gg = *(const f32x4*)(g + col), s1 = *(const f32x4*)(sc + (size_t)b * NMOD + col); A[j] = gg * (s1 + 1.0f); Bv[j] = *(const f32x4*)(sh + (size_t)b * NMOD + col); }
#pragma unroll 2
        for (int r = 0; r < 8; ++r) { const size_t row = (size_t)rb * 8 + r;
            f32x4 v[4]; float ss = 0.f;
#pragma unroll
            for (int j = 0; j < 4; ++j) { v[j] = *(const f32x4*)(xin + row * D + 4 * lane + 256 * j); ss += (v[j].x * v[j].x + v[j].y * v[j].y) + (v[j].z * v[j].z + v[j].w * v[j].w); }
            const float rstd = __builtin_amdgcn_rsqf(wave_sum(ss) * (1.f / D) + 1e-6f);
#pragma unroll
            for (int j = 0; j < 4; ++j) { const f32x4 o = v[j] * rstd * A[j] + Bv[j];
                unsigned long long w = (unsigned long long)cvtpk(o.x, o.y) | ((unsigned long long)cvtpk(o.z, o.w) << 32);
                *(unsigned long long*)(H + row * D + 4 * lane + 256 * j) = w; } }
    }
}

__device__ __forceinline__ s16x4 vtr(LAS const uchar* p) { return __builtin_amdgcn_ds_read_tr16_b64_v4i16((LAS s16x4*)p); }
__device__ __forceinline__ int crow(int r, int hi) { return (r & 3) + 8 * (r >> 2) + 4 * hi; }
__device__ __forceinline__ int voff(int row, int ch) { return 256 * row + 16 * (ch ^ (((row & 3) << 2) | ((row >> 2) & 3))); }
__device__ __forceinline__ int koff(int row, int ch) { return 128 * row + 16 * (ch ^ ((row >> 1) & 7)); }
__device__ __forceinline__ bf16x8 vfrag(LAS const uchar* vb, int ks, int c, int lane) {
    const int hi = lane >> 5, g1 = (lane >> 4) & 1, li = lane & 15, q = li >> 2, p = li & 3;
    const int ch = 4 * c + 2 * g1 + (p >> 1), r0 = 16 * ks + 4 * hi + q;
    const s16x4 lo = vtr(vb + voff(r0, ch) + 8 * (p & 1)), h4 = vtr(vb + voff(r0 + 8, ch) + 8 * (p & 1));
    return (bf16x8){lo[0], lo[1], lo[2], lo[3], h4[0], h4[1], h4[2], h4[3]};
}
__device__ __forceinline__ bf16x8 pack8f(const f32x16& p, int base) {
    u32x4 w; w.x = cvtpk(p[base + 0], p[base + 1]); w.y = cvtpk(p[base + 2], p[base + 3]); w.z = cvtpk(p[base + 4], p[base + 5]); w.w = cvtpk(p[base + 6], p[base + 7]);
    return __builtin_bit_cast(bf16x8, w);
}
#define MFMA32(a, b, c) __builtin_amdgcn_mfma_f32_32x32x16_bf16((a), (b), (c), 0, 0, 0)

__device__ __forceinline__ void attn_unit(LAS uchar* lds, int b, int h, int qb, const bf16* QA, const bf16* KA, const bf16* VA, bf16* OA, float negC, float lam, const float* subln) {
    const int tid = threadIdx.x, lane = tid & 63, wid = __builtin_amdgcn_readfirstlane(tid >> 6), qg = wid & 3, mp = wid >> 2, r32 = lane & 31, hi = lane >> 5;
    const size_t tokb = (size_t)b * SEQ; const int q0 = qb * 128 + qg * 32;
    bf16x8 qf[4];
    { const bf16* qp = QA + (tokb + q0 + r32) * 512 + h * 128 + mp * 64 + hi * 8;
#pragma unroll
      for (int s = 0; s < 4; ++s) qf[s] = *(const bf16x8*)(qp + 16 * s); }
    const int krow = tid >> 3, kch = tid & 7, vrow0 = tid >> 4, vch = tid & 15;
    const bf16* kg0 = KA + (tokb + krow) * 512 + h * 128 + kch * 8;
    const bf16* vg0 = VA + (tokb + vrow0) * 512 + h * 128 + vch * 8;
    const int kl = koff(krow, kch), vl0 = voff(vrow0, vch), vl1 = voff(vrow0 + 32, vch);
    u32x4 sk0, sk1, sv0, sv1;
#define AT_LOAD(t) do { const size_t o_ = (size_t)(t) * 64 * 512; sk0 = *(const u32x4*)(kg0 + o_); sk1 = *(const u32x4*)(kg0 + o_ + 64); sv0 = *(const u32x4*)(vg0 + o_); sv1 = *(const u32x4*)(vg0 + o_ + 32 * 512); } while (0)
#define AT_STORE(buf) do { LAS uchar* bb_ = lds + (buf) * 32768; *(LAS u32x4*)(bb_ + kl) = sk0; *(LAS u32x4*)(bb_ + 8192 + kl) = sk1; *(LAS u32x4*)(bb_ + 16384 + vl0) = sv0; *(LAS u32x4*)(bb_ + 16384 + vl1) = sv1; } while (0)
    AT_LOAD(0); AT_STORE(0); __syncthreads();
    f32x16 o[4];
#pragma unroll
    for (int c = 0; c < 4; ++c)
#pragma unroll
        for (int r = 0; r < 16; ++r) o[c][r] = 0.f;
    float lsum = 0.f;
    for (int kt = 0; kt < SEQ / 64; ++kt) {
        const int cur = kt & 1;
        if (kt + 1 < SEQ / 64) AT_LOAD(kt + 1);
        LAS const uchar* kb = lds + cur * 32768 + mp * 8192; LAS const uchar* vb = lds + cur * 32768 + 16384;
        f32x16 p0, p1;
#pragma unroll
        for (int r = 0; r < 16; ++r) { p0[r] = negC; p1[r] = negC; }
#pragma unroll
        for (int s = 0; s < 4; ++s) { const bf16x8 k0 = *(LAS const bf16x8*)(kb + koff(r32, 2 * s + hi)), k1 = *(LAS const bf16x8*)(kb + koff(32 + r32, 2 * s + hi));
            p0 = MFMA32(k0, qf[s], p0); p1 = MFMA32(k1, qf[s], p1); }
        float sa = 0.f, sb = 0.f;
#pragma unroll
        for (int r = 0; r < 16; ++r) { p0[r] = ex2(p0[r]); p1[r] = ex2(p1[r]); sa += p0[r]; sb += p1[r]; }
        lsum += sa + sb;
        const bf16x8 pw0 = pack8f(p0, 0), pw1 = pack8f(p0, 8), pw2 = pack8f(p1, 0), pw3 = pack8f(p1, 8);
#pragma unroll
        for (int c = 0; c < 4; ++c) {
            o[c] = MFMA32(pw0, vfrag(vb, 0, c, lane), o[c]); o[c] = MFMA32(pw1, vfrag(vb, 1, c, lane), o[c]);
            o[c] = MFMA32(pw2, vfrag(vb, 2, c, lane), o[c]); o[c] = MFMA32(pw3, vfrag(vb, 3, c, lane), o[c]);
 }
        if (kt + 1 < SEQ / 64) AT_STORE(cur ^ 1);
        __syncthreads();
    }
#undef AT_LOAD
#undef AT_STORE
    lsum += __shfl_xor(lsum, 32);
    LAS float* lb = (LAS float*)(lds + 98304) + wid * 32;
    if (hi == 0) lb[r32] = (mp ? lam : 1.f) / lsum;
    LDS_WAIT(); asm volatile("" ::: "memory");
    float rl[16];
#pragma unroll
    for (int r = 0; r < 16; ++r) rl[r] = lb[crow(r, hi)];
    LAS float* X = (LAS float*)lds + qg * 4096;
    if (mp == 1) {
#pragma unroll
        for (int c = 0; c < 4; ++c)
#pragma unroll
            for (int r = 0; r < 16; ++r) X[crow(r, hi) * 128 + 32 * c + r32] = o[c][r] * rl[r];
    }
    __syncthreads();
    if (mp == 0) {
        float ssq[16];
#pragma unroll
        for (int r = 0; r < 16; ++r) ssq[r] = 0.f;
#pragma unroll
        for (int c = 0; c < 4; ++c)
#pragma unroll
            for (int r = 0; r < 16; ++r) { const float v = o[c][r] * rl[r] - X[crow(r, hi) * 128 + 32 * c + r32]; o[c][r] = v; ssq[r] += v * v; }
#pragma unroll
        for (int r = 0; r < 16; ++r) {
#pragma unroll
            for (int x = 1; x < 32; x <<= 1) ssq[r] += __shfl_xor(ssq[r], x);
            ssq[r] = __builtin_amdgcn_rsqf(ssq[r] * (1.f / 128.f) + 1e-6f) * 0.8f; }
#pragma unroll
        for (int c = 0; c < 4; ++c) { const float sg = subln[32 * c + r32];
#pragma unroll
            for (int r = 0; r < 16; ++r) OA[(tokb + q0 + crow(r, hi)) * 512 + h * 128 + 32 * c + r32] = f2bf(o[c][r] * ssq[r] * sg); }
    }
    __syncthreads();
}

__device__ __forceinline__ void ret_state_task(LAS uchar* wl, int task, const bf16* KR, const bf16* VR, bf16* RT, const float* dec_f, const float* dec_b, int lane) {
    const int dt = task & 3, et = (task >> 2) & 7, dir = (task >> 5) & 1, h = (task >> 6) & 3, b = task >> 8;
    const float x = dir ? dec_b[h] : dec_f[h];
    const float lg2 = -log1pf(expf(-x)) * LOG2E, decay = ex2(128.f * lg2);
    f32x4 st = (f32x4){0.f, 0.f, 0.f, 0.f};
    const int g = lane >> 4, li = lane & 15, q = li >> 2, p = li & 3, hc = lane & 1;
    for (int step = 0; step < 16; ++step) {
        const int n = dir ? 15 - step : step;
        bf16* rt = RT + ((((size_t)(b * 4 + h) * 2 + dir) * 16 + n) * 128 + 16 * et) * 64 + 16 * dt;
#pragma unroll
        for (int r = 0; r < 4; ++r) rt[(4 * g + r) * 64 + li] = f2bf(st[r]);
        if (step == 15) break;
        const size_t tok0 = (size_t)b * SEQ + n * 128;
#pragma unroll
        for (int i = 0; i < 4; ++i) { const int row = 32 * i + (lane >> 1);
            const u32x4 vv = *(const u32x4*)(VR + (tok0 + row) * 512 + 128 * h + 16 * et + 8 * hc);
            const u32x4 kk = *(const u32x4*)(KR + (tok0 + row) * 256 + 64 * h + 16 * dt + 8 * hc);
            const float z = dir ? ex2((float)row * lg2) : ex2((float)(127 - row) * lg2);
            u32x4 ks; ks.x = cvtpk(pg8::bflo(kk.x) * z, pg8::bfhi(kk.x) * z); ks.y = cvtpk(pg8::bflo(kk.y) * z, pg8::bfhi(kk.y) * z); ks.z = cvtpk(pg8::bflo(kk.z) * z, pg8::bfhi(kk.z) * z); ks.w = cvtpk(pg8::bflo(kk.w) * z, pg8::bfhi(kk.w) * z);
            *(LAS u32x4*)(wl + row * 32 + 16 * hc) = vv; *(LAS u32x4*)(wl + 4096 + row * 32 + 16 * hc) = ks; }
        f32x4 acc = (f32x4){0.f, 0.f, 0.f, 0.f};
#pragma unroll
        for (int s = 0; s < 4; ++s) { const int ra = 32 * s + 8 * g + q;
            const s16x4 a0 = vtr(wl + ra * 32 + 8 * p), a1 = vtr(wl + (ra + 4) * 32 + 8 * p), b0 = vtr(wl + 4096 + ra * 32 + 8 * p), b1 = vtr(wl + 4096 + (ra + 4) * 32 + 8 * p);
            const bf16x8 A = (bf16x8){a0[0], a0[1], a0[2], a0[3], a1[0], a1[1], a1[2], a1[3]}, B = (bf16x8){b0[0], b0[1], b0[2], b0[3], b1[0], b1[1], b1[2], b1[3]};
            acc = __builtin_amdgcn_mfma_f32_16x16x32_bf16(A, B, acc, 0, 0, 0); }
        st = st * decay + acc;
        LDS_WAIT(); asm volatile("" ::: "memory");
    }
}

__device__ __forceinline__ void ret_unit(LAS uchar* lds, int b, int h, int n, const bf16* QR, const bf16* KR, bf16* VRY, const bf16* RT, const bf16* RG, const float* ret_norm, float lgf2, float lgb2, bool nostore) {
    int tid = threadIdx.x; asm volatile("" : "+v"(tid));
    const int lane = tid & 63, wid = __builtin_amdgcn_readfirstlane(tid >> 6), ib = wid & 3, eh = wid >> 2, r32 = lane & 31, hi = lane >> 5;
    const size_t tok0 = (size_t)b * SEQ + n * 128;
    { u32x4 tk[2], tv[4];
#pragma unroll
      for (int i = 0; i < 2; ++i) { const int pc = tid + 512 * i, row = pc >> 3, ch = pc & 7; tk[i] = *(const u32x4*)(KR + (tok0 + row) * 256 + 64 * h + 8 * ch); }
#pragma unroll
      for (int i = 0; i < 4; ++i) { const int pc = tid + 512 * i, row = pc >> 4, ch = pc & 15; tv[i] = *(const u32x4*)(VRY + (tok0 + row) * 512 + 128 * h + 8 * ch); }
#pragma unroll
      for (int i = 0; i < 2; ++i) { const int pc = tid + 512 * i, row = pc >> 3, ch = pc & 7; *(LAS u32x4*)(lds + koff(row, ch)) = tk[i]; }
#pragma unroll
      for (int i = 0; i < 4; ++i) { const int pc = tid + 512 * i, row = pc >> 4, ch = pc & 15; *(LAS u32x4*)(lds + 16384 + voff(row, ch)) = tv[i]; } }
    bf16x8 qf[4];
    { const bf16* qp = QR + (tok0 + 32 * ib + r32) * 256 + 64 * h + 8 * hi;
#pragma unroll
      for (int s = 0; s < 4; ++s) qf[s] = *(const bf16x8*)(qp + 16 * s); }
    __syncthreads();
    f32x16 y[2];
#pragma unroll
    for (int cc = 0; cc < 2; ++cc) {
        const bf16* rF = RT + ((((size_t)(b * 4 + h) * 2 + 0) * 16 + n) * 128 + 64 * eh + 32 * cc + r32) * 64 + 8 * hi;
        const bf16* rB = rF + (size_t)16 * 128 * 64;
        f32x16 af, ab;
#pragma unroll
        for (int r = 0; r < 16; ++r) { af[r] = 0.f; ab[r] = 0.f; }
#pragma unroll
        for (int s = 0; s < 4; ++s) { const bf16x8 bf_ = *(const bf16x8*)(rF + 16 * s), bb_ = *(const bf16x8*)(rB + 16 * s); af = MFMA32(qf[s], bf_, af); ab = MFMA32(qf[s], bb_, ab); }
#pragma unroll
        for (int r = 0; r < 16; ++r) { const int i = 32 * ib + crow(r, hi); y[cc][r] = ex2((float)(i + 1) * lgf2) * af[r] + ex2((float)(128 - i) * lgb2) * ab[r]; }
    }
    LAS const uchar* vb = lds + 16384;
#pragma unroll
    for (int jb = 0; jb < 4; ++jb) {
        f32x16 st;
#pragma unroll
        for (int r = 0; r < 16; ++r) st[r] = 0.f;
#pragma unroll
        for (int s = 0; s < 4; ++s) { const bf16x8 kf = *(LAS const bf16x8*)(lds + koff(32 * jb + r32, 2 * s + hi)); st = MFMA32(kf, qf[s], st); }
#pragma unroll
        for (int r = 0; r < 16; ++r) { const int df = (32 * ib + r32) - (32 * jb + crow(r, hi));
            const float fac = df > 0 ? ex2((float)df * lgf2) : (df < 0 ? ex2((float)(-df) * lgb2) : 2.0f); st[r] *= fac; }
        const bf16x8 pw0 = pack8f(st, 0), pw1 = pack8f(st, 8);
#pragma unroll
        for (int cc = 0; cc < 2; ++cc) { y[cc] = MFMA32(pw0, vfrag(vb, 2 * jb, 2 * eh + cc, lane), y[cc]); y[cc] = MFMA32(pw1, vfrag(vb, 2 * jb + 1, 2 * eh + cc, lane), y[cc]); }
    }
    float ssq[16];
#pragma unroll
    for (int r = 0; r < 16; ++r) { float v = y[0][r] * y[0][r] + y[1][r] * y[1][r];
#pragma unroll
        for (int x = 1; x < 32; x <<= 1) v += __shfl_xor(v, x);
        ssq[r] = v; }
    LAS float* sbuf = (LAS float*)(lds + 49152);
    if (r32 == 0) {
#pragma unroll
        for (int r = 0; r < 16; ++r) sbuf[wid * 32 + crow(r, hi)] = ssq[r]; }
    __syncthreads();
#pragma unroll
    for (int r = 0; r < 16; ++r) ssq[r] = __builtin_amdgcn_rsqf((ssq[r] + sbuf[(wid ^ 4) * 32 + crow(r, hi)]) * (1.f / 128.f) + 1e-6f);
#pragma unroll
    for (int cc = 0; cc < 2; ++cc) { const int e = 64 * eh + 32 * cc + r32; const float gn = ret_norm[e];
#pragma unroll
        for (int r = 0; r < 16; ++r) { const size_t off = (tok0 + 32 * ib + crow(r, hi)) * 512 + 128 * h + e; const unsigned short ov = f2bf(y[cc][r] * ssq[r] * gn * bf2f(RG[off])); if (!nostore) VRY[off] = ov; } }
    __syncthreads();
}
#define RLX_AGENT __ATOMIC_RELAXED, __HIP_MEMORY_SCOPE_AGENT
#define XB_TMO      128
#define XB_XCNT(j)  (256  + 64 * (j))
#define XB_XSUB(j)  (1280 + 64 * (j))
#define XB_XGEN(j)  (2304 + 64 * (j))
#define XB_TOP      3328
#define XB_TOPGEN   3392
#define XCD_BAR_WORDS 3456
#define XB_SPIN_CAP (1u << 18)

__device__ __forceinline__ unsigned xb_ld(unsigned* p)              { return __hip_atomic_load(p, __ATOMIC_RELAXED, __HIP_MEMORY_SCOPE_AGENT); }
__device__ __forceinline__ unsigned xb_add(unsigned* p, unsigned v) { return __hip_atomic_fetch_add(p, v, __ATOMIC_RELAXED, __HIP_MEMORY_SCOPE_AGENT); }
__device__ __forceinline__ unsigned xb_xcc_id() { return (unsigned)__builtin_amdgcn_s_getreg((3 << 11) | 20) & 0xFu; }
#define XB_SPIN(cond, bar) do { unsigned _sp = 0; while (cond) { __builtin_amdgcn_s_sleep(1); \
    if ((++_sp & 255u) == 0u) { if (xb_ld(&(bar)[XB_TMO])) break; if (_sp > XB_SPIN_CAP) { atomicAdd(&(bar)[XB_TMO], 1u); break; } } } } while (0)

struct XcdBarrier {
    unsigned* bar; unsigned x;
    volatile LAS unsigned* st;
};

__device__ __forceinline__ XcdBarrier xcd_barrier_post(unsigned* bar, volatile LAS unsigned* st) {
    XcdBarrier b; b.bar = bar; b.x = xb_xcc_id(); b.st = st;
    if (threadIdx.x == 0) (void)xb_add(&bar[XB_XCNT(b.x)], 1u);
    return b;
}
__device__ __forceinline__ void xcd_barrier_complete(unsigned* bar, unsigned x, unsigned& nloc, unsigned& nx) {
    const unsigned G = gridDim.x * gridDim.y * gridDim.z;
    unsigned sum, cnt, mine, sp = 0u;
    for (;;) {
        sum = 0u; cnt = 0u; mine = 0u;
#pragma unroll
        for (unsigned j = 0; j < 16; ++j) { const unsigned c = xb_ld(&bar[XB_XCNT(j)]); sum += c; cnt += (c > 0u) ? 1u : 0u; mine = (j == x) ? c : mine; }
        if (sum == G) break;
        __builtin_amdgcn_s_sleep(1);
        if ((++sp & 255u) == 0u) { if (xb_ld(&bar[XB_TMO])) break; if (sp > XB_SPIN_CAP) { atomicAdd(&bar[XB_TMO], 1u); break; } }
    }
    nloc = mine > 0u ? mine : 1u; nx = cnt > 0u ? cnt : 1u;
}

__device__ __forceinline__ void xcd_barrier(const XcdBarrier& b) {
    asm volatile("s_waitcnt vmcnt(0)" ::: "memory");
    __syncthreads();
    if (threadIdx.x == 0) {
        unsigned* bar = b.bar;
        __builtin_amdgcn_s_waitcnt(0);
        unsigned nloc = b.st[0], nx = b.st[1];
        if (nloc == 0u) { xcd_barrier_complete(bar, b.x, nloc, nx); b.st[0] = nloc; b.st[1] = nx; }
        const unsigned old = xb_add(&bar[XB_XSUB(b.x)], 1u);
        const unsigned gen = old / nloc;
        if (old + 1u == (gen + 1u) * nloc) {
            __builtin_amdgcn_fence(__ATOMIC_RELEASE, "agent");
            asm volatile("s_waitcnt vmcnt(0)" ::: "memory");
            const unsigned og = xb_add(&bar[XB_TOP], 1u);
            const unsigned tg = og / nx;
            if (og + 1u == (tg + 1u) * nx) xb_add(&bar[XB_TOPGEN], 1u);
            else XB_SPIN(xb_ld(&bar[XB_TOPGEN]) == tg, bar);
            __builtin_amdgcn_fence(__ATOMIC_ACQUIRE, "agent");
            xb_add(&bar[XB_XGEN(b.x)], 1u);
            asm volatile("s_waitcnt vmcnt(0)" ::: "memory");
        } else {
            XB_SPIN(xb_ld(&bar[XB_XGEN(b.x)]) == gen, bar);
            __builtin_amdgcn_fence(__ATOMIC_ACQUIRE, "agent");
            asm volatile("s_waitcnt vmcnt(0)" ::: "memory");
        }
    }
    __syncthreads();
}

#ifndef MK_N_LAUNCHES
#define MK_N_LAUNCHES 1
#endif
constexpr int N_PHASES = 12;
__global__ void __launch_bounds__(NWAVES * 64, 2) mk_fwd(Args args) {
    extern __shared__ __attribute__((aligned(16))) unsigned char lds_raw[];
    LAS uchar* lds = (LAS uchar*)lds_raw;
    cg::grid_group grid = cg::this_grid();
    const int tid = threadIdx.x, lane = tid & 63, wave = __builtin_amdgcn_readfirstlane(tid >> 6);
    const int G = gridDim.x, bx = blockIdx.x, vcu = (G % 8 == 0) ? (bx % 8) * (G / 8) + bx / 8 : bx;
    const int gw = vcu * NWAVES + wave, NGW = G * NWAVES;
    uchar* ws = args.ws;
    volatile LAS unsigned* MISC = (volatile LAS unsigned*)(lds + RING_BYTES + 320);
    if (tid < 64) ((LAS unsigned*)(lds + RING_BYTES))[tid * 2] = 0u, ((LAS unsigned*)(lds + RING_BYTES))[tid * 2 + 1] = 0u;
    __syncthreads();
    XcdBarrier bar = xcd_barrier_post((unsigned*)(ws + WS_CTL + 512 * 1024), MISC + 8);
#define x (args.in[0])
#define cvec (args.in[1])
#define positions ((const int*)args.in[2])
#define w_ada (args.in[3])
#define b_ada (args.in[4])
#define out (args.out)
#define mod ((float*)(ws + WS_MOD))
#define W13A ((bf16*)(ws + WS_W13A))
#define W2A ((bf16*)(ws + WS_W2A))
#define WIN ((bf16*)(ws + WS_WIN))
#define WA ((bf16*)(ws + WS_WA))
#define WR ((bf16*)(ws + WS_WR))
#define WO ((bf16*)(ws + WS_WO))
#define W13B ((bf16*)(ws + WS_W13B))
#define W2B ((bf16*)(ws + WS_W2B))
#define cosA ((float*)(ws + WS_TAB))
#define sinA ((float*)(ws + WS_TAB + 2 * MiB))
#define cosR ((float*)(ws + WS_TAB + 4 * MiB))
#define sinR ((float*)(ws + WS_TAB + 6 * MiB))
#define H ((bf16*)(ws + WS_H))
#define RT ((bf16*)(ws + WS_H))
#define U ((bf16*)(ws + WS_Z))
#define QA ((bf16*)(ws + WS_QA))
#define KA ((bf16*)(ws + WS_KA))
#define VA ((bf16*)(ws + WS_VA))
#define QR ((bf16*)(ws + WS_QR))
#define KR ((bf16*)(ws + WS_KR))
#define VR ((bf16*)(ws + WS_VR))
#define RG ((bf16*)(ws + WS_RG))
#define GA ((bf16*)(ws + WS_GA))
#define GR ((bf16*)(ws + WS_GR))
#define T ((bf16*)(ws + WS_T))
#define OA ((bf16*)(ws + WS_H + 16 * MiB))
    const int lo = args.ph_lo, hi_ph = args.ph_hi;
#ifndef PHMASK
#define PHMASK 0xffff
#endif
#define IN(k) (((PHMASK >> (k)) & 1) && lo <= (k) && (k) < hi_ph)
#ifndef DUPMASK
#define DUPMASK 0
#endif
#define REPS(k) _Pragma("unroll") for (int rep_ = 0; rep_ < (((DUPMASK >> (k)) & 1) ? 2 : 1); ++rep_)
#define SEAM(k) do { if (IN(k) && IN((k) + 1)) { if ((k) == 0) grid.sync(); else xcd_barrier(bar); } } while (0)

    if (IN(0)) REPS(0) {
        LAS float* scr = (LAS float*)(lds + wave * 16384);
        constexpr int I13 = 16 * 176, I2 = 44 * 32, IIN = 16 * 160, IBR = 8 * 32, IO = 16 * 32;
        constexpr int NITEMS = 2 * I13 + 2 * I2 + IIN + 2 * IBR + IO;
        for (int it = gw; it < NITEMS; it += NGW) {
            int r = it;
            if (r < I13) { tr_w13(args.in[6], args.in[7], W13A, r, scr, lane); continue; } r -= I13;
            if (r < I2) { tr_plain(args.in[8], FF, D, W2A, r, scr, lane); continue; } r -= I2;
            if (r < IIN) { tr_win(args.in[10], WIN, r, scr, lane); continue; } r -= IIN;
            if (r < IBR) { tr_plain(args.in[22], 512, D, WA, r, scr, lane); continue; } r -= IBR;
            if (r < IBR) { tr_plain(args.in[23], 512, D, WR, r, scr, lane); continue; } r -= IBR;
            if (r < IO) { tr_plain(args.in[24], D, D, WO, r, scr, lane); continue; } r -= IO;
            if (r < I13) { tr_w13(args.in[26], args.in[27], W13B, r, scr, lane); continue; } r -= I13;
            tr_plain(args.in[28], FF, D, W2B, r, scr, lane);
        }
        if (rep_ == 0) for (int task = gw; task < 144 * 16; task += NGW) {
            const int cgp = task % 144, ks = task / 144, n = 64 * cgp + lane;
            float sv[8], a[8];
#pragma unroll
            for (int b = 0; b < 8; ++b) { sv[b] = pg8::silu(cvec[b * D + 64 * ks + lane]); a[b] = 0.f; }
#pragma unroll 8
            for (int kk = 0; kk < 64; ++kk) { const float w = w_ada[(size_t)(64 * ks + kk) * NMOD + n];
#pragma unroll
                for (int b = 0; b < 8; ++b) a[b] += __uint_as_float(__builtin_amdgcn_readlane(__float_as_uint(sv[b]), kk)) * w; }
            const float bias = ks == 0 ? b_ada[n] : 0.f;
#pragma unroll
            for (int b = 0; b < 8; ++b) atomicAdd(mod + (size_t)b * NMOD + n, a[b] + bias);
        }
        for (int idx = (vcu * NWAVES * 64 + tid); idx < M * 32; idx += G * NWAVES * 64) {
            const int tok = idx >> 5, i = idx & 31; const double pos = (double)positions[tok];
            const double TWO_PI_HI = 6.283185307179586, TWO_PI_LO = 2.4492935982947064e-16, INV2PI = 0.15915494309189535;
            { const double inv = exp2(-13.287712379549449 * (double)i / 32.0); const double a = pos * inv, k = rint(a * INV2PI); double r = fma(-k, TWO_PI_HI, a); r = fma(-k, TWO_PI_LO, r); const float rf = (float)r; cosA[idx] = cosf(rf); sinA[idx] = sinf(rf); }
            { const double inv = exp2(-13.287712379549449 * (double)i / 31.0); const double a = pos * inv, k = rint(a * INV2PI); double r = fma(-k, TWO_PI_HI, a); r = fma(-k, TWO_PI_LO, r); const float rf = (float)r; cosR[idx] = cosf(rf); sinR[idx] = sinf(rf); }
        }
    }
    SEAM(0);
#ifdef XSYNC
    for (int i_ = 0; i_ < XSYNC; ++i_) xcd_barrier(bar);
#endif
    if (IN(1)) REPS(1) norm_phase(x, args.in[5], mod + 0 * D, mod + 1 * D, H, gw, NGW, lane);
    SEAM(1);
    if (IN(2)) REPS(2) { pg8::Gemm g{H, W13A, M, 2 * FF, D}; pg8::StaticOrder S; S.init(M, 2 * FF, G, bx); pg8::EpiUp E{U, FF};
        pg8::gemm_phase<pg8::EpiUp, pg8::StaticOrder, true, true>(lds, g, S, E); }
    SEAM(2);
    if (IN(3)) REPS(3) { pg8::Gemm g{U, W2A, M, D, FF}; pg8::StaticOrder S; S.init(M, D, G, bx); pg8::EpiRes E{x, out, mod + 2 * D, 0.5f};
        pg8::gemm_phase<pg8::EpiRes, pg8::StaticOrder, true, true>(lds, g, S, E); }
    SEAM(3);
    if (IN(4)) norm_phase(out, args.in[9], mod + 3 * D, mod + 4 * D, H, gw, NGW, lane);
    SEAM(4);
    if (IN(5)) REPS(5) { pg8::Gemm g{H, WIN, M, NIN, D}; pg8::StaticOrder S; S.init(M, NIN, G, bx);
        pg8::EpiIn E{ws, args.in[12], args.in[13], args.in[11], QSCALE};
        static_assert(pg8::EpiIn::oTAB == WS_TAB && pg8::EpiIn::oZ == WS_Z && pg8::EpiIn::oGR == WS_GR && pg8::EpiIn::oVR == WS_VR, "EpiIn workspace map");
        pg8::gemm_phase<pg8::EpiIn, pg8::StaticOrder, true, true>(lds, g, S, E); }
    SEAM(5);
    if (IN(6)) REPS(6) { for (int task = gw; task < 2048; task += NGW) ret_state_task(lds + wave * 8192, task, KR, VR, RT, args.in[19], args.in[20], lane); }
    SEAM(6);
    if (IN(7)) {
        const float l1 = wave_sum(args.in[14][lane] * args.in[15][lane]), l2 = wave_sum(args.in[16][lane] * args.in[17][lane]);
        const float lam = expf(l1) - expf(l2) + 0.2f;
        float mq = fabsf(args.in[12][lane]), mk = fabsf(args.in[13][lane]);
#pragma unroll
        for (int o = 1; o < 64; o <<= 1) { mq = fmaxf(mq, __shfl_xor(mq, o)); mk = fmaxf(mk, __shfl_xor(mk, o)); }
        const float negC = -(8.0f * LOG2E * mq * mk);
#ifndef NO_ATT
        _Pragma("unroll 1") for (int rep_ = 0; rep_ < (((DUPMASK >> 7) & 1) ? 2 : 1); ++rep_) for (int u = vcu; u < 512; u += G) attn_unit(lds, u >> 6, (u >> 4) & 3, u & 15, QA, KA, VA, OA, negC, lam, args.in[18]);
#endif
#ifndef NO_RET
        for (int u = vcu; u < 512; u += G) { const int b = u >> 6, h = (u >> 4) & 3;
            const float lgf2 = -log1pf(expf(-args.in[19][h])) * LOG2E, lgb2 = -log1pf(expf(-args.in[20][h])) * LOG2E;
#ifdef RETDUP
            ret_unit(lds, b, h, u & 15, QR, KR, VR, RT, RG, args.in[21], lgf2, lgb2, args.ph_lo != 12345);
#endif
            ret_unit(lds, b, h, u & 15, QR, KR, VR, RT, RG, args.in[21], lgf2, lgb2, false); }
#endif
    }
    SEAM(7);
    if (IN(8)) {
        { pg8::Gemm g{OA, WA, M, D, 512}; pg8::StaticOrder S; S.init(M, D, G, bx); pg8::EpiBr<0> E{T, GA}; pg8::gemm_phase<pg8::EpiBr<0>, pg8::StaticOrder, true, true>(lds, g, S, E); }
        { pg8::Gemm g{VR, WR, M, D, 512}; pg8::StaticOrder S; S.init(M, D, G, bx); pg8::EpiBr<1> E{T, GR}; pg8::gemm_phase<pg8::EpiBr<1>, pg8::StaticOrder, true, true>(lds, g, S, E); }
    }
    SEAM(8);
    if (IN(9)) { pg8::Gemm g{T, WO, M, D, D}; pg8::StaticOrder S; S.init(M, D, G, bx); pg8::EpiRes E{out, out, mod + 5 * D, 1.0f};
        pg8::gemm_phase<pg8::EpiRes, pg8::StaticOrder, true, true>(lds, g, S, E); }
    SEAM(9);
    if (IN(10)) norm_phase(out, args.in[25], mod + 6 * D, mod + 7 * D, H, gw, NGW, lane);
    SEAM(10);
    if (IN(11)) { pg8::Gemm g{H, W13B, M, 2 * FF, D}; pg8::StaticOrder S; S.init(M, 2 * FF, G, bx); pg8::EpiUp E{U, FF};
        pg8::gemm_phase<pg8::EpiUp, pg8::StaticOrder, true, true>(lds, g, S, E); }
    SEAM(11);
    if (IN(12)) { pg8::Gemm g{U, W2B, M, D, FF}; pg8::StaticOrder S; S.init(M, D, G, bx); pg8::EpiRes E{out, out, mod + 8 * D, 0.5f};
        pg8::gemm_phase<pg8::EpiRes, pg8::StaticOrder, true, true>(lds, g, S, E); }
#undef IN
#undef SEAM
}

#undef x
#undef cvec
#undef positions
#undef w_ada
#undef b_ada
#undef out
#undef mod
#undef W13A
#undef W2A
#undef WIN
#undef WA
#undef WR
#undef WO
#undef W13B
#undef W2B
#undef cosA
#undef sinA
#undef cosR
#undef sinR
#undef H
#undef RT
#undef U
#undef QA
#undef KA
#undef VA
#undef QR
#undef KR
#undef VR
#undef RG
#undef GA
#undef GR
#undef T
#undef OA
extern "C" void kernel_launch(void* const* d_in, const int* in_sizes, int n_in, void* d_out, int out_size, void* d_ws, size_t ws_size, hipStream_t stream) {
    static int grid = 0;
    if (grid == 0) {
        if (n_in != 29 || out_size != M * D || ws_size < WS_END) { fprintf(stderr, "kernel_launch: unexpected shapes (n_in %d out %d ws %zu)\n", n_in, out_size, ws_size); grid = -1; return; }
        int dev = 0, cus = 0, per_cu = 0;
        (void)hipGetDevice(&dev); (void)hipDeviceGetAttribute(&cus, hipDeviceAttributeMultiprocessorCount, dev);
        if (hipFuncSetAttribute((const void*)mk_fwd, hipFuncAttributeMaxDynamicSharedMemorySize, LDS_BYTES) != hipSuccess) { fprintf(stderr, "kernel_launch: hipFuncSetAttribute failed\n"); grid = -1; return; }
        if (hipOccupancyMaxActiveBlocksPerMultiprocessor(&per_cu, (const void*)mk_fwd, NWAVES * 64, LDS_BYTES) != hipSuccess || per_cu < 1) { fprintf(stderr, "kernel_launch: occupancy query says %d\n", per_cu); per_cu = 1; }
        (void)hipGetLastError();
        grid = cus * 1;
        if (grid <= 0) grid = 256;
    }
    if (grid < 0) return;
    (void)hipMemsetAsync((char*)d_ws + WS_CTL, 0, CTL_ZERO_BYTES, stream);
    Args a{};
    for (int i = 0; i < 29; ++i) a.in[i] = (const float*)d_in[i];
    a.out = (float*)d_out; a.ws = (unsigned char*)d_ws;
#if MK_N_LAUNCHES == 1
    a.ph_lo = 0; a.ph_hi = N_PHASES + 1;
    void* kargs[] = {&a};
    hipError_t e = hipLaunchCooperativeKernel((const void*)mk_fwd, dim3(grid), dim3(NWAVES * 64), kargs, LDS_BYTES, stream);
    if (e != hipSuccess) fprintf(stderr, "kernel_launch: cooperative launch failed: %s (grid %d)\n", hipGetErrorString(e), grid);
#else
    for (int p = 0; p <= N_PHASES; ++p) { a.ph_lo = p; a.ph_hi = p + 1; hipLaunchKernelGGL(mk_fwd, dim3(grid), dim3(NWAVES * 64), LDS_BYTES, stream, a); }
#endif
}
```

```cpp
#include <hip/hip_runtime.h>
#include <hip/hip_cooperative_groups.h>
#include <cstdio>
#include <cstdint>
#include <cmath>
namespace cg = cooperative_groups;


namespace pg8 {
#define PG8_LAS __attribute__((address_space(3)))
typedef unsigned short bf16_t;
typedef short bf16x8 __attribute__((ext_vector_type(8)));
typedef float f32x4 __attribute__((ext_vector_type(4)));
typedef unsigned u32x4 __attribute__((ext_vector_type(4)));
constexpr int BM = 256, BK = 64, HALF = 128, HTB = HALF * BK * 2  , STAGE_BYTES = 8 * HTB, NXCD = 8, WGM = 8;

__host__ __device__ __forceinline__ int lds_byte(int r, int c) { const int st = (r >> 4) * 2 + (c >> 5), rr = r & 15, cc = c & 31, ob = rr * 64 + cc * 2; return st * 1024 + (ob ^ (((ob >> 9) & 1) << 5)); }
__host__ __device__ __forceinline__ void stage_rc(int b, int& R, int& C) { const int st = b / 1024, sb = b % 1024, swz = sb ^ (((sb >> 9) & 1) << 5); R = (st >> 1) * 16 + swz / 64; C = (st & 1) * 32 + (swz % 64) / 2; }
__host__ __device__ __forceinline__ int perm32(int rho) { const int n = rho >> 4, i = rho & 15; return 8 * (i >> 2) + 4 * n + (i & 3); }

struct Unit { int pm, pn; };
struct Gemm { const bf16_t* A; const bf16_t* Bt; int M, N, K; };

struct StaticOrder {
    int nM, nN, nwg, G, c;
    __host__ __device__ void init(int M, int N, int G_, int c_) { nM = M / BM; nN = N / BM; nwg = nM * nN; G = G_; c = c_; }
    __host__ __device__ bool next(int i, Unit& u) const {
        const long L = (long)i * G + c; if (L >= nwg) return false;
        int wgid = (int)L; { const int q = nwg / NXCD, r = nwg % NXCD, xcd = wgid % NXCD, off = wgid / NXCD; wgid = (xcd < r ? xcd * (q + 1) : r * (q + 1) + (xcd - r) * q) + off; }
        const int nig = WGM * nN, gid = wgid / nig, fm = gid * WGM, gsz = (nM - fm) < WGM ? (nM - fm) : WGM;
        u.pm = fm + ((wgid % nig) % gsz); u.pn = (wgid % nig) / gsz; return true;
    }
    __device__ __forceinline__ void a_ready(const Unit&) const {}
    __device__ __forceinline__ void done(const Unit&) const {}
};

__device__ __forceinline__ unsigned cvt_pk_bf16(float lo, float hi) { unsigned r; asm volatile("v_cvt_pk_bf16_f32 %0, %1, %2" : "=v"(r) : "v"(lo), "v"(hi)); return r; }
typedef float f32x2 __attribute__((ext_vector_type(2)));
__device__ __forceinline__ float bflo(unsigned w) { return __uint_as_float(w << 16); }
__device__ __forceinline__ float bfhi(unsigned w) { return __uint_as_float(w & 0xffff0000u); }
__device__ __forceinline__ float sigm(float v) { return __builtin_amdgcn_rcpf(1.f + __builtin_amdgcn_exp2f(-1.4426950408889634f * v)); }
__device__ __forceinline__ float silu(float v) { return v * sigm(v); }
__device__ __forceinline__ u32x4 pack8(const float (&o)[8]) { u32x4 w; w.x = cvt_pk_bf16(o[0], o[1]); w.y = cvt_pk_bf16(o[2], o[3]); w.z = cvt_pk_bf16(o[4], o[5]); w.w = cvt_pk_bf16(o[6], o[7]); return w; }

struct EpiUp {
    static constexpr bool PERM = true, AFTER_DRAIN = false, PREFETCH = true;
    __device__ __forceinline__ void prefetch(const Unit& u, PG8_LAS unsigned char* side, int tid, int wid) const {
        const float* src = wid < 4 ? rss + u.pm * BM + tid : bias + (size_t)(u.pm >> 3) * 5632 + u.pn * BM + (tid - 256);
        __builtin_amdgcn_global_load_lds((const unsigned*)src, (PG8_LAS unsigned*)(side + wid * 256), 4, 0, 0);
    }
    bf16_t* U; int ldu; const float* rss; const float* bias;
    __device__ __forceinline__ void operator()(const f32x4 (&acc)[2][2][4][2], const Unit& u, int wr, int wc, int fr, int fq, PG8_LAS const unsigned char* side) const {
        const int row0 = u.pm * BM + wr * 64 + fr, col0 = u.pn * 128 + wc * 32 + 8 * fq;
        f32x4 bv[2][2];
#pragma unroll
        for (int bj = 0; bj < 2; ++bj)
#pragma unroll
            for (int n = 0; n < 2; ++n) bv[bj][n] = *(PG8_LAS const f32x4*)(side + 1024 + 4 * (bj * HALF + wc * 32 + 8 * fq + 4 * n));
#pragma unroll
        for (int ai = 0; ai < 2; ++ai)
#pragma unroll
            for (int m = 0; m < 4; ++m) {
                const float rs = __builtin_amdgcn_rsqf(*(PG8_LAS const float*)(side + 4 * (ai * HALF + wr * 64 + m * 16 + fr)) * (1.f / 1024.f) + 1e-6f);
                float o[8];
#pragma unroll
                for (int n = 0; n < 2; ++n)
#pragma unroll
                    for (int e = 0; e < 4; ++e) o[4 * n + e] = silu(acc[ai][0][m][n][e] * rs + bv[0][n][e]) * (acc[ai][1][m][n][e] * rs + bv[1][n][e]);
                __builtin_nontemporal_store(pack8(o), (u32x4*)(U + (size_t)(row0 + ai * HALF + m * 16) * ldu + col0));
            }
    }
};
template <bool IN16, bool OUT16, bool NEXT, int SC2> struct EpiRes {
    static constexpr bool PERM = true, AFTER_DRAIN = false, PREFETCH = false;
    const void* xin; void* xout; const float* gate;
    bf16_t* Hn; const float* gn; const float* scn; float* rssn;
    __device__ __forceinline__ void operator()(const f32x4 (&acc)[2][2][4][2], const Unit& u, int wr, int wc, int fr, int fq) const {
        const int b = u.pm >> 3, col0 = u.pn * BM + wc * 32 + 8 * fq;
        f32x4 gv[2][2], an[2][2];
#pragma unroll
        for (int bj = 0; bj < 2; ++bj)
#pragma unroll
            for (int n = 0; n < 2; ++n) { gv[bj][n] = *(const f32x4*)(gate + (size_t)b * 9216 + col0 + bj * HALF + 4 * n) * (0.5f * (float)SC2);
                if (NEXT) an[bj][n] = *(const f32x4*)(gn + col0 + bj * HALF + 4 * n) * (*(const f32x4*)(scn + (size_t)b * 9216 + col0 + bj * HALF + 4 * n) + 1.0f); }
#pragma unroll
        for (int ai = 0; ai < 2; ++ai)
#pragma unroll
            for (int m = 0; m < 4; ++m) { const int row = u.pm * BM + ai * HALF + wr * 64 + m * 16 + fr; float ss = 0.f;
#pragma unroll
                for (int bj = 0; bj < 2; ++bj) { const size_t off = (size_t)row * 1024 + col0 + bj * HALF;
                    f32x4 x0, x1;
                    if (IN16) { const u32x4 w = *(const u32x4*)((const bf16_t*)xin + off); x0 = (f32x4){bflo(w.x), bfhi(w.x), bflo(w.y), bfhi(w.y)}; x1 = (f32x4){bflo(w.z), bfhi(w.z), bflo(w.w), bfhi(w.w)}; }
                    else { x0 = *(const f32x4*)((const float*)xin + off); x1 = *(const f32x4*)((const float*)xin + off + 4); }
                    x0 = x0 + gv[bj][0] * acc[ai][bj][m][0]; x1 = x1 + gv[bj][1] * acc[ai][bj][m][1];
                    if (OUT16) { u32x4 w; w.x = cvt_pk_bf16(x0[0], x0[1]); w.y = cvt_pk_bf16(x0[2], x0[3]); w.z = cvt_pk_bf16(x1[0], x1[1]); w.w = cvt_pk_bf16(x1[2], x1[3]); *(u32x4*)((bf16_t*)xout + off) = w; }
                    else { *(f32x4*)((float*)xout + off) = x0; *(f32x4*)((float*)xout + off + 4) = x1; }
                    if (NEXT) { ss += ((x0[0] * x0[0] + x0[1] * x0[1]) + (x0[2] * x0[2] + x0[3] * x0[3])) + ((x1[0] * x1[0] + x1[1] * x1[1]) + (x1[2] * x1[2] + x1[3] * x1[3]));
                        const f32x4 h0 = x0 * an[bj][0], h1 = x1 * an[bj][1]; u32x4 w; w.x = cvt_pk_bf16(h0[0], h0[1]); w.y = cvt_pk_bf16(h0[2], h0[3]); w.z = cvt_pk_bf16(h1[0], h1[1]); w.w = cvt_pk_bf16(h1[2], h1[3]);
                        *(u32x4*)(Hn + off) = w; } }
                if (NEXT) { ss += __shfl_xor(ss, 16); ss += __shfl_xor(ss, 32); if (fq == 0) atomicAdd(rssn + row, ss); } }
    }
};
struct EpiIn {
    static constexpr bool PERM = true, AFTER_DRAIN = false, PREFETCH = true;
    __device__ __forceinline__ void prefetch(const Unit& u, PG8_LAS unsigned char* side, int tid, int wid) const {
        const float* src = wid < 4 ? rss + u.pm * BM + tid : bias + (size_t)(u.pm >> 3) * 5120 + u.pn * BM + (tid - 256);
        __builtin_amdgcn_global_load_lds((const unsigned*)src, (PG8_LAS unsigned*)(side + wid * 256), 4, 0, 0);
    }
    unsigned char* ws; const float *gq, *gk, *bmerge; float qscale; const float* rss; const float* bias;
    static constexpr size_t Mi = 1u << 20, oTAB = 50 * Mi, oZ = 90 * Mi;
    static constexpr size_t oQA = oZ, oKA = oZ + 16 * Mi, oVA = oZ + 32 * Mi, oQR = oZ + 48 * Mi, oKR = oZ + 56 * Mi, oVR = oZ + 64 * Mi, oRG = oZ + 80 * Mi, oGA = oZ + 96 * Mi, oGR = oZ + 128 * Mi;
    __device__ __forceinline__ void operator()(const f32x4 (&acc)[2][2][4][2], const Unit& u, int wr, int wc, int fr, int fq, PG8_LAS const unsigned char* side) const {
        const int pn = u.pn, row0 = u.pm * BM + wr * 64 + fr, d0 = 8 * fq;
        { f32x4 (&accw)[2][2][4][2] = const_cast<f32x4 (&)[2][2][4][2]>(acc);
          f32x4 bz[2][2];
#pragma unroll
          for (int bj = 0; bj < 2; ++bj)
#pragma unroll
              for (int n = 0; n < 2; ++n) bz[bj][n] = *(PG8_LAS const f32x4*)(side + 1024 + 4 * (bj * HALF + wc * 32 + d0 + 4 * n));
#pragma unroll
          for (int ai = 0; ai < 2; ++ai)
#pragma unroll
              for (int m = 0; m < 4; ++m) { const float rs = __builtin_amdgcn_rsqf(*(PG8_LAS const float*)(side + 4 * (ai * HALF + wr * 64 + m * 16 + fr)) * (1.f / 1024.f) + 1e-6f);
#pragma unroll
                  for (int bj = 0; bj < 2; ++bj)
#pragma unroll
                      for (int n = 0; n < 2; ++n) accw[ai][bj][m][n] = accw[ai][bj][m][n] * rs + bz[bj][n]; }
          asm volatile("" ::: "memory"); }
#define ZV(ai, bj, m, n, e) (acc[ai][bj][m][n][e])
        if (pn < 4) {
            const bool isq = pn < 2; bf16_t* dst = (bf16_t*)(ws + (isq ? oQA : oKA)); const float* cosA = (const float*)(ws + oTAB); const float* sinA = (const float*)(ws + oTAB + 2 * Mi); const float* g = isq ? gq : gk; const float osc = isq ? qscale : 1.f;
            const int hh = 4 * (pn & 1) + wc;
            float g0[8], g1[8];
#pragma unroll
            for (int e = 0; e < 8; ++e) { g0[e] = g[d0 + e]; g1[e] = g[32 + d0 + e]; }
#pragma unroll
            for (int ai = 0; ai < 2; ++ai)
#pragma unroll
                for (int m = 0; m < 4; ++m) { const int row = row0 + ai * HALF + m * 16;
                    float x0[8], x1[8], ss = 0.f;
#pragma unroll
                    for (int n = 0; n < 2; ++n)
#pragma unroll
                        for (int e = 0; e < 4; ++e) { x0[4 * n + e] = ZV(ai, 0, m, n, e); x1[4 * n + e] = ZV(ai, 1, m, n, e); }
#pragma unroll
                    for (int e = 0; e < 8; ++e) ss += x0[e] * x0[e] + x1[e] * x1[e];
                    ss += __shfl_xor(ss, 16); ss += __shfl_xor(ss, 32);
                    const float rstd = __builtin_amdgcn_rsqf(ss * (1.f / 64.f) + 1e-6f);
                    const f32x4 c0 = *(const f32x4*)(cosA + (size_t)row * 32 + d0), c1 = *(const f32x4*)(cosA + (size_t)row * 32 + d0 + 4);
                    const f32x4 s0 = *(const f32x4*)(sinA + (size_t)row * 32 + d0), s1 = *(const f32x4*)(sinA + (size_t)row * 32 + d0 + 4);
                    float o0[8], o1[8];
#pragma unroll
                    for (int e = 0; e < 8; ++e) { const float c = e < 4 ? c0[e & 3] : c1[e & 3], s = e < 4 ? s0[e & 3] : s1[e & 3];
                        const float a = x0[e] * rstd * g0[e], bb = x1[e] * rstd * g1[e]; o0[e] = (a * c - bb * s) * osc; o1[e] = (bb * c + a * s) * osc; }
                    bf16_t* p = dst + (size_t)row * 512 + 64 * hh + d0;
                    *(u32x4*)p = pack8(o0); *(u32x4*)(p + 32) = pack8(o1); }
        } else if (pn == 6 || pn == 7) {
            bf16_t* dst = (bf16_t*)(ws + (pn == 6 ? oQR : oKR)); const float* cosR = (const float*)(ws + oTAB + 4 * Mi); const float* sinR = (const float*)(ws + oTAB + 6 * Mi); const float osc = pn == 6 ? 1.f : 0.125f;
#pragma unroll
            for (int ai = 0; ai < 2; ++ai)
#pragma unroll
                for (int m = 0; m < 4; ++m) { const int row = row0 + ai * HALF + m * 16;
                    const f32x4 c0 = *(const f32x4*)(cosR + (size_t)row * 32 + d0), c1 = *(const f32x4*)(cosR + (size_t)row * 32 + d0 + 4);
                    const f32x4 s0 = *(const f32x4*)(sinR + (size_t)row * 32 + d0), s1 = *(const f32x4*)(sinR + (size_t)row * 32 + d0 + 4);
                    float o0[8], o1[8];
#pragma unroll
                    for (int n = 0; n < 2; ++n)
#pragma unroll
                        for (int e = 0; e < 4; ++e) { const float c = n == 0 ? c0[e] : c1[e], s = n == 0 ? s0[e] : s1[e]; const float xe = ZV(ai, 0, m, n, e), xo = ZV(ai, 1, m, n, e);
                            o0[4 * n + e] = (xe * c - xo * s) * osc; o1[4 * n + e] = (xo * c + xe * s) * osc; }
                    bf16_t* p = dst + (size_t)row * 256 + 64 * wc + d0;
                    *(u32x4*)p = pack8(o0); *(u32x4*)(p + 32) = pack8(o1); }
        } else {
            bf16_t* dst; int ld, cb, op; const float* bias = nullptr;
            if (pn < 6) { dst = (bf16_t*)(ws + oVA); ld = 512; cb = 256 * (pn - 4); op = 0; }
            else if (pn < 10) { dst = (bf16_t*)(ws + oVR); ld = 512; cb = 256 * (pn - 8); op = 0; }
            else if (pn < 12) { dst = (bf16_t*)(ws + oRG); ld = 512; cb = 256 * (pn - 10); op = 1; }
            else if (pn < 16) { dst = (bf16_t*)(ws + oGA); ld = 1024; cb = 256 * (pn - 12); op = 2; bias = bmerge; }
            else { dst = (bf16_t*)(ws + oGR); ld = 1024; cb = 256 * (pn - 16); op = 2; bias = bmerge + 1024; }
#pragma unroll
            for (int bj = 0; bj < 2; ++bj) { const int col = cb + bj * HALF + wc * 32 + d0;
                f32x4 b0 = (f32x4){0.f, 0.f, 0.f, 0.f}, b1 = b0; if (op == 2) { b0 = *(const f32x4*)(bias + col); b1 = *(const f32x4*)(bias + col + 4); }
#pragma unroll
                for (int ai = 0; ai < 2; ++ai)
#pragma unroll
                    for (int m = 0; m < 4; ++m) { const int row = row0 + ai * HALF + m * 16; float o[8];
#pragma unroll
                        for (int e = 0; e < 4; ++e) { float v0 = ZV(ai, bj, m, 0, e) + b0[e], v1 = ZV(ai, bj, m, 1, e) + b1[e];
                            if (op == 1) { v0 = silu(v0); v1 = silu(v1); } else if (op == 2) { v0 = sigm(v0); v1 = sigm(v1); }
                            o[e] = v0; o[4 + e] = v1; }
                        *(u32x4*)(dst + (size_t)row * ld + col) = pack8(o); } }
        }
#undef ZV
    }
};
template <int MODE> struct EpiBr {
    static constexpr bool PERM = true, AFTER_DRAIN = false, PREFETCH = false;
    bf16_t* T; const bf16_t* G;
    __device__ __forceinline__ void operator()(const f32x4 (&acc)[2][2][4][2], const Unit& u, int wr, int wc, int fr, int fq) const {
        const int row0 = u.pm * BM + wr * 64 + fr, col0 = u.pn * BM + wc * 32 + 8 * fq;
#pragma unroll
        for (int ai = 0; ai < 2; ++ai)
#pragma unroll
            for (int m = 0; m < 4; ++m)
#pragma unroll
                for (int bj = 0; bj < 2; ++bj) { const size_t off = (size_t)(row0 + ai * HALF + m * 16) * 1024 + col0 + bj * HALF;
                    const u32x4 gw = *(const u32x4*)(G + off); u32x4 tw = (u32x4){0u, 0u, 0u, 0u}; if (MODE == 1) tw = *(const u32x4*)(T + off);
                    const f32x4 a0 = acc[ai][bj][m][0], a1 = acc[ai][bj][m][1]; float o[8];
                    o[0] = bflo(gw.x) * a0[0]; o[1] = bfhi(gw.x) * a0[1]; o[2] = bflo(gw.y) * a0[2]; o[3] = bfhi(gw.y) * a0[3];
                    o[4] = bflo(gw.z) * a1[0]; o[5] = bfhi(gw.z) * a1[1]; o[6] = bflo(gw.w) * a1[2]; o[7] = bfhi(gw.w) * a1[3];
                    if (MODE == 1) { o[0] += bflo(tw.x); o[1] += bfhi(tw.x); o[2] += bflo(tw.y); o[3] += bfhi(tw.y); o[4] += bflo(tw.z); o[5] += bfhi(tw.z); o[6] += bflo(tw.w); o[7] += bfhi(tw.w); }
                    *(u32x4*)(T + off) = pack8(o); }
    }
};
template <class Epi, class Sched, bool ALIGN_EPI = false, bool SP2 = false>
__device__ __forceinline__ void gemm_phase(PG8_LAS unsigned char* lds, const Gemm g, const Sched& S, const Epi& E) {
    const int tid = threadIdx.x, wid = __builtin_amdgcn_readfirstlane(tid >> 6), lane = tid & 63, wr = wid >> 2, wc = wid & 3, fr = lane & 15, fq = lane >> 4;
    const int K = g.K, nt = K / BK;
    unsigned voffA[2], voffB[2];
#pragma unroll
    for (int i = 0; i < 2; ++i) { int R, C; stage_rc(tid * 16 + i * 8192, R, C); const int Rb = Epi::PERM ? ((R & ~31) + perm32(R & 31)) : R;
        voffA[i] = (unsigned)(R * K + C) * 2u; voffB[i] = (unsigned)(Rb * K + C) * 2u; }
    const size_t kstep = (size_t)(BK * 2);
    const size_t hstep = (size_t)HALF * K * 2;
    const size_t tstep = 2 * hstep;
    const unsigned ldsw = (unsigned)wid * 1024u;
    const int aoff = lds_byte(wr * 64 + fr, fq * 8), boff = lds_byte(wc * 32 + fr, fq * 8);
#define PG8_SA(b, h) (((b) * 2 + (h)) * HTB)
#define PG8_SB(b, h) ((4 + (b) * 2 + (h)) * HTB)
#define PG8_STAGE(bufoff, gbase, voff) do { _Pragma("unroll") for (int _i = 0; _i < 2; ++_i) \
        __builtin_amdgcn_global_load_lds((const unsigned*)((const char*)(gbase) + (voff)[_i]), (PG8_LAS unsigned*)(lds + (bufoff) + ldsw + _i * 8192), 16, 0, 0); } while (0)
#define PG8_LDA(dst, b, h) do { _Pragma("unroll") for (int m = 0; m < 4; ++m) _Pragma("unroll") for (int k = 0; k < 2; ++k) dst[m][k] = *(const PG8_LAS bf16x8*)(lds + PG8_SA(b, h) + aoff + m * 2048 + k * 1024); } while (0)
#define PG8_LDB(dst, b, h) do { _Pragma("unroll") for (int n = 0; n < 2; ++n) _Pragma("unroll") for (int k = 0; k < 2; ++k) dst[n][k] = *(const PG8_LAS bf16x8*)(lds + PG8_SB(b, h) + boff + n * 2048 + k * 1024); } while (0)
#define PG8_MMA(ai, bj, At, Bt) do { __builtin_amdgcn_s_setprio(1); _Pragma("unroll") for (int m = 0; m < 4; ++m) _Pragma("unroll") for (int n = 0; n < 2; ++n) _Pragma("unroll") for (int k = 0; k < 2; ++k) \
        acc[ai][bj][m][n] = __builtin_amdgcn_mfma_f32_16x16x32_bf16(Bt[n][k], At[m][k], acc[ai][bj][m][n], 0, 0, 0); __builtin_amdgcn_s_setprio(0); } while (0)
#define PG8_WAIT_V(n) asm volatile("s_waitcnt vmcnt(" #n ")" ::: "memory")
#define PG8_WAIT_L(n) asm volatile("s_waitcnt lgkmcnt(" #n ")" ::: "memory")
#define PG8_BAR __builtin_amdgcn_s_barrier()
#define PG8_SCHED __builtin_amdgcn_sched_barrier(0)
    Unit cur, nxt; int ui = 0;
    if (!S.next(0, cur)) return;
    f32x4 acc[2][2][4][2];
#pragma unroll
    for (int a = 0; a < 2; ++a)
#pragma unroll
        for (int b = 0; b < 2; ++b)
#pragma unroll
            for (int m = 0; m < 4; ++m)
#pragma unroll
                for (int n = 0; n < 2; ++n) acc[a][b][m][n] = (f32x4){0.f, 0.f, 0.f, 0.f};
    bf16x8 At[4][2], B0[2][2], B1[2][2];
    const char* cA = (const char*)g.A + (size_t)cur.pm * tstep; const char* cB = (const char*)g.Bt + (size_t)cur.pn * tstep;
    S.a_ready(cur);
    if constexpr (SP2) {
        PG8_STAGE(PG8_SB(0, 0), cB, voffB); PG8_STAGE(PG8_SB(0, 1), cB + hstep, voffB); PG8_STAGE(PG8_SA(0, 0), cA, voffA); PG8_STAGE(PG8_SA(0, 1), cA + hstep, voffA);
        if (wr == 1) PG8_BAR;
        PG8_WAIT_V(2); PG8_BAR;
        PG8_STAGE(PG8_SB(1, 0), cB + kstep, voffB); PG8_STAGE(PG8_SA(1, 0), cA + kstep, voffA); PG8_STAGE(PG8_SB(1, 1), cB + hstep + kstep, voffB);
        PG8_WAIT_V(6); PG8_BAR;
    } else {
        PG8_STAGE(PG8_SB(0, 0), cB, voffB); PG8_STAGE(PG8_SA(0, 0), cA, voffA); PG8_STAGE(PG8_SB(0, 1), cB + hstep, voffB); PG8_STAGE(PG8_SA(0, 1), cA + hstep, voffA);
        if (wr == 1) PG8_BAR;
        PG8_WAIT_V(4); PG8_BAR;
        PG8_STAGE(PG8_SB(1, 0), cB + kstep, voffB); PG8_STAGE(PG8_SA(1, 0), cA + kstep, voffA); PG8_STAGE(PG8_SB(1, 1), cB + hstep + kstep, voffB);
        PG8_WAIT_V(6); PG8_BAR;
    }
    for (;;) {
        const bool has_next = S.next(ui + 1, nxt);
        PG8_LAS unsigned char* const side = lds + 132096 + (ui & 1) * 2048;
        if constexpr (Epi::PREFETCH) E.prefetch(cur, side, tid, wid);
        const char* nA = has_next ? (const char*)g.A + (size_t)nxt.pm * tstep : cA; const char* nB = has_next ? (const char*)g.Bt + (size_t)nxt.pn * tstep : cB;
        for (int t = 0; t < nt; t += 2) {
            const bool last = (t == nt - 2);
            const char* a1 = cA + (size_t)(t + 1) * kstep;
            const char* a2 = last ? nA : cA + (size_t)(t + 2) * kstep; const char* b2 = last ? nB : cB + (size_t)(t + 2) * kstep;
            const char* a3 = a2 + kstep; const char* b3 = b2 + kstep;
            if (last && has_next) S.a_ready(nxt);
            if constexpr (SP2) {
            PG8_LDB(B0, 0, 0); PG8_LDB(B1, 0, 1); PG8_SCHED; PG8_LDA(At, 0, 0); PG8_STAGE(PG8_SA(1, 1), a1 + hstep, voffA);
            PG8_WAIT_V(8); PG8_WAIT_L(0); PG8_BAR; PG8_MMA(0, 0, At, B0); PG8_MMA(0, 1, At, B1); PG8_BAR; PG8_SCHED;
            PG8_LDA(At, 0, 1); PG8_STAGE(PG8_SB(0, 0), b2, voffB); PG8_STAGE(PG8_SB(0, 1), b2 + hstep, voffB); PG8_STAGE(PG8_SA(0, 0), a2, voffA);
            PG8_WAIT_V(8); PG8_WAIT_L(0); PG8_BAR; PG8_MMA(1, 0, At, B0); PG8_MMA(1, 1, At, B1); PG8_BAR; PG8_SCHED;
            PG8_LDB(B0, 1, 0); PG8_LDB(B1, 1, 1); PG8_SCHED; PG8_LDA(At, 1, 0); PG8_STAGE(PG8_SA(0, 1), a2 + hstep, voffA);
            PG8_WAIT_V(8); PG8_WAIT_L(0); PG8_BAR; PG8_MMA(0, 0, At, B0); PG8_MMA(0, 1, At, B1); PG8_BAR; PG8_SCHED;
            PG8_LDA(At, 1, 1); PG8_STAGE(PG8_SB(1, 0), b3, voffB); PG8_STAGE(PG8_SB(1, 1), b3 + hstep, voffB); PG8_STAGE(PG8_SA(1, 0), a3, voffA);
            PG8_WAIT_V(8); PG8_WAIT_L(0); PG8_BAR; PG8_MMA(1, 0, At, B0); PG8_MMA(1, 1, At, B1); PG8_BAR; PG8_SCHED;
            } else {
            PG8_LDB(B0, 0, 0); PG8_SCHED; PG8_LDA(At, 0, 0); PG8_STAGE(PG8_SA(1, 1), a1 + hstep, voffA);
            PG8_WAIT_L(8); PG8_BAR; PG8_WAIT_L(0); PG8_MMA(0, 0, At, B0); PG8_BAR; PG8_SCHED;
            PG8_LDB(B1, 0, 1); PG8_STAGE(PG8_SB(0, 0), b2, voffB);
            PG8_BAR; PG8_WAIT_L(0); PG8_MMA(0, 1, At, B1); PG8_BAR;
            PG8_LDA(At, 0, 1); PG8_STAGE(PG8_SA(0, 0), a2, voffA);
            PG8_BAR; PG8_WAIT_L(0); PG8_MMA(1, 0, At, B0); PG8_BAR; PG8_SCHED;
            PG8_STAGE(PG8_SB(0, 1), b2 + hstep, voffB);
            PG8_WAIT_V(6); PG8_BAR; PG8_MMA(1, 1, At, B1); PG8_BAR;
            PG8_LDB(B0, 1, 0); PG8_SCHED; PG8_LDA(At, 1, 0); PG8_STAGE(PG8_SA(0, 1), a2 + hstep, voffA);
            PG8_WAIT_L(8); PG8_BAR; PG8_WAIT_L(0); PG8_MMA(0, 0, At, B0); PG8_BAR; PG8_SCHED;
            PG8_LDB(B1, 1, 1); PG8_STAGE(PG8_SB(1, 0), b3, voffB);
            PG8_BAR; PG8_WAIT_L(0); PG8_MMA(0, 1, At, B1); PG8_BAR;
            PG8_LDA(At, 1, 1); PG8_STAGE(PG8_SA(1, 0), a3, voffA);
            PG8_BAR; PG8_WAIT_L(0); PG8_MMA(1, 0, At, B0); PG8_BAR; PG8_SCHED;
            PG8_STAGE(PG8_SB(1, 1), b3 + hstep, voffB);
            PG8_WAIT_V(6); PG8_BAR; PG8_MMA(1, 1, At, B1); PG8_BAR;
            }
        }
        if constexpr (ALIGN_EPI) { if (wr == 0) PG8_BAR; }
        if constexpr (!Epi::AFTER_DRAIN) { if constexpr (Epi::PREFETCH) E(acc, cur, wr, wc, fr, fq, side); else E(acc, cur, wr, wc, fr, fq); S.done(cur); }
        if (!has_next) break;
#pragma unroll
        for (int a = 0; a < 2; ++a)
#pragma unroll
            for (int b = 0; b < 2; ++b)
#pragma unroll
                for (int m = 0; m < 4; ++m)
#pragma unroll
                    for (int n = 0; n < 2; ++n) acc[a][b][m][n] = (f32x4){0.f, 0.f, 0.f, 0.f};
        cur = nxt; cA = nA; cB = nB; ++ui;
        if constexpr (ALIGN_EPI) { if (wr == 1) PG8_BAR; }
    }
    PG8_WAIT_V(0);
    if constexpr (!ALIGN_EPI) { if (wr == 0) PG8_BAR; }
    PG8_BAR;
    if constexpr (Epi::AFTER_DRAIN) { E.fused(acc, cur, wr, wc, fr, fq, lds, wid, lane); S.done(cur); }
#undef PG8_SA
#undef PG8_SB
#undef PG8_STAGE
#undef PG8_LDA
#undef PG8_LDB
#undef PG8_MMA
#undef PG8_WAIT_V
#undef PG8_WAIT_L
#undef PG8_BAR
#undef PG8_SCHED
}
}
#define LAS __attribute__((address_space(3)))
typedef unsigned short bf16;
typedef unsigned u32x4 __attribute__((ext_vector_type(4)));
typedef float f32x4 __attribute__((ext_vector_type(4)));
typedef float f32x16 __attribute__((ext_vector_type(16)));
typedef short bf16x8 __attribute__((ext_vector_type(8)));
typedef short s16x4 __attribute__((ext_vector_type(4)));
typedef unsigned char uchar;
constexpr int NWAVES = 8;
constexpr int BATCH = 8, SEQ = 2048, D = 1024, FF = 2816, NIN = 5120, M = BATCH * SEQ, NMOD = 9 * D;
constexpr float LOG2E = 1.4426950408889634f;
constexpr float QSCALE = 0.125f * LOG2E;
constexpr size_t MiB = 1u << 20;
constexpr size_t WS_CTL = 0, CTL_ZERO_BYTES = 1 * MiB, WS_MOD = 65536;
constexpr size_t WS_W13A = 2 * MiB, WS_W2A = 13 * MiB, WS_WIN = 19 * MiB, WS_WA = 29 * MiB, WS_WR = 30 * MiB, WS_WO = 31 * MiB, WS_W13B = 33 * MiB, WS_W2B = 44 * MiB;
constexpr size_t WS_TAB = 50 * MiB;
constexpr size_t WS_H = 58 * MiB;
constexpr size_t WS_Z = 90 * MiB;
constexpr size_t WS_QA = WS_Z, WS_KA = WS_Z + 16 * MiB, WS_VA = WS_Z + 32 * MiB, WS_QR = WS_Z + 48 * MiB, WS_KR = WS_Z + 56 * MiB, WS_VR = WS_Z + 64 * MiB, WS_RG = WS_Z + 80 * MiB, WS_GA = WS_Z + 96 * MiB, WS_GR = WS_Z + 128 * MiB;
constexpr size_t WS_T = WS_KA;
constexpr size_t WS_END = 250 * MiB;
constexpr int RING_BYTES = 131072, LDS_BYTES = 147456;

#define LDS_WAIT() asm volatile("s_waitcnt lgkmcnt(0)" ::: "memory")
__device__ __forceinline__ unsigned cvtpk(float lo, float hi) { unsigned r; asm volatile("v_cvt_pk_bf16_f32 %0, %1, %2" : "=v"(r) : "v"(lo), "v"(hi)); return r; }
__device__ __forceinline__ float bf2f(unsigned short v) { return __uint_as_float((unsigned)v << 16); }
__device__ __forceinline__ unsigned short f2bf(float f) { return (unsigned short)(cvtpk(f, 0.f) & 0xffffu); }
__device__ __forceinline__ float wave_sum(float v) {
#pragma unroll
    for (int o = 1; o < 64; o <<= 1) v += __shfl_xor(v, o);
    return v;
}
__device__ __forceinline__ float ex2(float v) { return __builtin_amdgcn_exp2f(v); }

struct Args { const float* in[29]; float* out; unsigned char* ws; int ph_lo, ph_hi; };

__device__ __forceinline__ void tr_item(const float* W, int Nsrc, int scol0, int cstride, int k0, bf16* WT, int Kdst, int drow0, LAS float* scr, int lane) {
    if (cstride == 1) {
        f32x4 v[8]; const int c4 = lane & 7, kq = lane >> 3;
#pragma unroll
        for (int i = 0; i < 8; ++i) v[i] = __builtin_nontemporal_load((const f32x4*)(W + (size_t)(k0 + 8 * i + kq) * Nsrc + scol0 + 4 * c4));
#pragma unroll
        for (int i = 0; i < 8; ++i) { LAS float* d = scr + (8 * i + kq) * 33 + 4 * c4; d[0] = v[i].x; d[1] = v[i].y; d[2] = v[i].z; d[3] = v[i].w; }
    } else {
#pragma unroll 8
        for (int i = 0; i < 32; ++i) { const int kk = 2 * i + (lane >> 5); scr[kk * 33 + (lane & 31)] = W[(size_t)(k0 + kk) * Nsrc + scol0 + (lane & 31) * cstride]; }
    }
    LDS_WAIT(); asm volatile("" ::: "memory");
    const int c = lane & 7;
#pragma unroll
    for (int j = 0; j < 4; ++j) { const int n = (lane >> 3) + 8 * j; const LAS float* s = scr + (8 * c) * 33 + n;
        u32x4 o; o.x = cvtpk(s[0 * 33], s[1 * 33]); o.y = cvtpk(s[2 * 33], s[3 * 33]); o.z = cvtpk(s[4 * 33], s[5 * 33]); o.w = cvtpk(s[6 * 33], s[7 * 33]);
        *(u32x4*)(WT + (size_t)(drow0 + n) * Kdst + k0 + 8 * c) = o; }
    LDS_WAIT(); asm volatile("" ::: "memory");
}
__device__ __forceinline__ void tr_w13(const float* w1, const float* w3, bf16* WT, int it, LAS float* scr, int lane) {
    const int kb = it / 176, nb = it % 176, n0 = 32 * nb, pn = n0 >> 8, bj = (n0 >> 7) & 1, j0 = n0 & 127;
    tr_item(bj ? w3 : w1, FF, 128 * pn + j0, 1, 64 * kb, WT, D, n0, scr, lane);
}
__device__ __forceinline__ void tr_plain(const float* W, int K, int N, bf16* WT, int it, LAS float* scr, int lane) {
    const int nblk = N / 32, kb = it / nblk, nb = it % nblk;
    tr_item(W, N, 32 * nb, 1, 64 * kb, WT, K, 32 * nb, scr, lane);
}
__device__ __forceinline__ void tr_win(const float* W, bf16* WT, int it, LAS float* scr, int lane) {
    const int kb = it / 160, nb = it % 160, n0 = 32 * nb, pn = n0 >> 8, bj = (n0 >> 7) & 1, wc = (n0 >> 5) & 3;
    int scol0 = n0, cs = 1;
    if (pn < 4) scol0 = 256 * pn + 64 * wc + 32 * bj;
    else if (pn == 6 || pn == 7) { scol0 = 256 * pn + 64 * wc + bj; cs = 2; }
    tr_item(W, NIN, scol0, cs, 64 * kb, WT, D, n0, scr, lane);
}
__device__ __forceinline__ void norm_phase(const float* xin, const float* g, const float* sc, bf16* Hd, float* rss, int gw, int NGW, int lane) {
    for (int rb = gw; rb < M / 8; rb += NGW) {
        const int b = rb >> 8;
        f32x4 A[4];
#pragma unroll
        for (int j = 0; j < 4; ++j) { const int col = 4 * lane + 256 * j; const f32x4 gg = *(const f32x4*)(g + col), s1 = *(const f32x4*)(sc + (size_t)b * NMOD + col); A[j] = gg * (s1 + 1.0f); }
#pragma unroll 4
        for (int r = 0; r < 8; ++r) { const size_t row = (size_t)rb * 8 + r;
            f32x4 v[4]; float ss = 0.f;
#pragma unroll
            for (int j = 0; j < 4; ++j) { v[j] = __builtin_nontemporal_load((const f32x4*)(xin + row * D + 4 * lane + 256 * j)); ss += (v[j][0] * v[j][0] + v[j][1] * v[j][1]) + (v[j][2] * v[j][2] + v[j][3] * v[j][3]); }
            ss = wave_sum(ss); if (lane == 0) rss[row] = ss;
#pragma unroll
            for (int j = 0; j < 4; ++j) { const f32x4 o = v[j] * A[j];
                unsigned long long w = (unsigned long long)cvtpk(o[0], o[1]) | ((unsigned long long)cvtpk(o[2], o[3]) << 32);
                *(unsigned long long*)(Hd + row * D + 4 * lane + 256 * j) = w; } }
    }
}
__device__ __forceinline__ void bias_rows(const bf16* Wt, int N, const float* sh, float* biasv, int w0, int NW_, int lane) {
    f32x4 sv[8][4];
#pragma unroll
    for (int b = 0; b < 8; ++b)
#pragma unroll
        for (int q = 0; q < 4; ++q) sv[b][q] = *(const f32x4*)(sh + (size_t)b * NMOD + 16 * lane + 4 * q);
    for (int n0 = w0; n0 < N; n0 += 2 * NW_) {
        u32x4 wa[2], wb[2];
#pragma unroll
        for (int j = 0; j < 2; ++j) { const int n = n0 + j * NW_; const int nn = n < N ? n : w0; wa[j] = *(const u32x4*)(Wt + (size_t)nn * D + 16 * lane); wb[j] = *(const u32x4*)(Wt + (size_t)nn * D + 16 * lane + 8); }
#pragma unroll
        for (int j = 0; j < 2; ++j) { const int n = n0 + j * NW_;
            float wf[16];
            wf[0] = pg8::bflo(wa[j][0]); wf[1] = pg8::bfhi(wa[j][0]); wf[2] = pg8::bflo(wa[j][1]); wf[3] = pg8::bfhi(wa[j][1]); wf[4] = pg8::bflo(wa[j][2]); wf[5] = pg8::bfhi(wa[j][2]); wf[6] = pg8::bflo(wa[j][3]); wf[7] = pg8::bfhi(wa[j][3]);
            wf[8] = pg8::bflo(wb[j][0]); wf[9] = pg8::bfhi(wb[j][0]); wf[10] = pg8::bflo(wb[j][1]); wf[11] = pg8::bfhi(wb[j][1]); wf[12] = pg8::bflo(wb[j][2]); wf[13] = pg8::bfhi(wb[j][2]); wf[14] = pg8::bflo(wb[j][3]); wf[15] = pg8::bfhi(wb[j][3]);
            float res = 0.f;
#pragma unroll
            for (int b = 0; b < 8; ++b) { float d = 0.f;
#pragma unroll
                for (int q = 0; q < 4; ++q) d += (wf[4 * q] * sv[b][q][0] + wf[4 * q + 1] * sv[b][q][1]) + (wf[4 * q + 2] * sv[b][q][2] + wf[4 * q + 3] * sv[b][q][3]);
                d = wave_sum(d); if (lane == b) res = d; }
            if (lane < 8 && n < N) biasv[(size_t)lane * N + n] = res; }
    }
}

__device__ __forceinline__ s16x4 vtr(LAS const uchar* p) { return __builtin_amdgcn_ds_read_tr16_b64_v4i16((LAS s16x4*)p); }
__device__ __forceinline__ int crow(int r, int hi) { return (r & 3) + 8 * (r >> 2) + 4 * hi; }
__device__ __forceinline__ int voff(int row, int ch) { return 256 * row + 16 * (ch ^ (((row & 3) << 2) | ((row >> 2) & 3))); }
__device__ __forceinline__ int koff(int row, int ch) { return 128 * row + 16 * (ch ^ ((row >> 1) & 7)); }
__device__ __forceinline__ bf16x8 vfrag(LAS const uchar* vb, int ks, int c, int lane) {
    const int hi = lane >> 5, g1 = (lane >> 4) & 1, li = lane & 15, q = li >> 2, p = li & 3;
    const int ch = 4 * c + 2 * g1 + (p >> 1), r0 = 16 * ks + 4 * hi + q;
    const s16x4 lo = vtr(vb + voff(r0, ch) + 8 * (p & 1)), h4 = vtr(vb + voff(r0 + 8, ch) + 8 * (p & 1));
    return (bf16x8){lo[0], lo[1], lo[2], lo[3], h4[0], h4[1], h4[2], h4[3]};
}
__device__ __forceinline__ bf16x8 pack8f(const f32x16& p, int base) {
    u32x4 w; w.x = cvtpk(p[base + 0], p[base + 1]); w.y = cvtpk(p[base + 2], p[base + 3]); w.z = cvtpk(p[base + 4], p[base + 5]); w.w = cvtpk(p[base + 6], p[base + 7]);
    return __builtin_bit_cast(bf16x8, w);
}
#define MFMA32(a, b, c) __builtin_amdgcn_mfma_f32_32x32x16_bf16((a), (b), (c), 0, 0, 0)

__device__ __forceinline__ void attn_unit(LAS uchar* lds, int b, int h, int qb, const bf16* QA, const bf16* KA, const bf16* VA, bf16* OA, float negC, float lam, const float* subln) {
    const int tid = threadIdx.x, lane = tid & 63, wid = __builtin_amdgcn_readfirstlane(tid >> 6), qg = wid & 3, mp = wid >> 2, r32 = lane & 31, hi = lane >> 5;
    const size_t tokb = (size_t)b * SEQ; const int q0 = qb * 128 + qg * 32;
    bf16x8 qf[4];
    { const bf16* qp = QA + (tokb + q0 + r32) * 512 + h * 128 + mp * 64 + hi * 8;
#pragma unroll
      for (int s = 0; s < 4; ++s) qf[s] = *(const bf16x8*)(qp + 16 * s); }
    const int krow = tid >> 3, kch = (tid & 7) ^ ((krow >> 1) & 7), vrow0 = tid >> 4, vch = (tid & 15) ^ (((vrow0 & 3) << 2) | ((vrow0 >> 2) & 3));
    const bf16* kg0 = KA + (tokb + krow) * 512 + h * 128 + kch * 8;
    const bf16* vg0 = VA + (tokb + vrow0) * 512 + h * 128 + vch * 8;
#define AT_DMAK(t, koff_) do { const size_t o_ = (size_t)((t) < SEQ / 64 ? (t) : SEQ / 64 - 1) * 64 * 512; LAS uchar* bb_ = lds + (koff_) + wid * 1024; \
        __builtin_amdgcn_global_load_lds((const unsigned*)(kg0 + o_), (LAS unsigned*)(bb_), 16, 0, 0); \
        __builtin_amdgcn_global_load_lds((const unsigned*)(kg0 + o_ + 64), (LAS unsigned*)(bb_ + 8192), 16, 0, 0); } while (0)
#define AT_DMAV(t, voff_) do { const size_t o_ = (size_t)((t) < SEQ / 64 ? (t) : SEQ / 64 - 1) * 64 * 512; LAS uchar* bb_ = lds + 65536 + (voff_) + wid * 1024; \
        __builtin_amdgcn_global_load_lds((const unsigned*)(vg0 + o_), (LAS unsigned*)(bb_), 16, 0, 0); \
        __builtin_amdgcn_global_load_lds((const unsigned*)(vg0 + o_ + 32 * 512), (LAS unsigned*)(bb_ + 8192), 16, 0, 0); } while (0)
#define SGB(mask, n) __builtin_amdgcn_sched_group_barrier((mask), (n), 0)
    AT_DMAK(0, 0); AT_DMAK(1, 16384); AT_DMAK(2, 32768); AT_DMAV(0, 0); AT_DMAV(1, 16384);
    asm volatile("s_waitcnt vmcnt(0)" ::: "memory"); __syncthreads();
    int kb0, vb0;
    { const int y = (r32 >> 1) & 7; kb0 = 128 * r32 + 16 * (hi ^ y);
      const int g1 = (lane >> 4) & 1, li = lane & 15, q = li >> 2, p_ = li & 3;
      vb0 = 256 * (4 * hi + q) + 16 * ((q << 2) | ((2 * g1 + (p_ >> 1)) ^ (hi & 3))) + 8 * (p_ & 1); }
    f32x16 o[4];
#pragma unroll
    for (int c = 0; c < 4; ++c)
#pragma unroll
        for (int r = 0; r < 16; ++r) o[c][r] = 0.f;
    float lsum = 0.f;
    f32x16 pA0, pA1;
    { LAS const uchar* kb = lds + mp * 8192;
#pragma unroll
      for (int r = 0; r < 16; ++r) { pA0[r] = negC; pA1[r] = negC; }
#pragma unroll
      for (int s = 0; s < 4; ++s) { const bf16x8 k0 = *(LAS const bf16x8*)(kb + (kb0 ^ (s << 5))), k1 = *(LAS const bf16x8*)(kb + (kb0 ^ (s << 5)) + 4096);
          pA0 = MFMA32(k0, qf[s], pA0); pA1 = MFMA32(k1, qf[s], pA1); } }
    int k1o = 16384, k3o = 49152, v0o = 0, v2o = 32768;
    if (mp) __builtin_amdgcn_s_setprio(2);
    for (int kt = 0; kt < SEQ / 64; ++kt) {
        AT_DMAK(kt + 3, k3o); AT_DMAV(kt + 2, v2o);
        LAS const uchar* kbn = lds + k1o + mp * 8192; LAS const uchar* vb = lds + 65536 + v0o;
        __builtin_amdgcn_sched_barrier(0);
        f32x16 pB0, pB1;
#pragma unroll
        for (int r = 0; r < 16; ++r) { pB0[r] = negC; pB1[r] = negC; }
#pragma unroll
        for (int s = 0; s < 4; ++s) { const bf16x8 k0 = *(LAS const bf16x8*)(kbn + (kb0 ^ (s << 5))), k1 = *(LAS const bf16x8*)(kbn + (kb0 ^ (s << 5)) + 4096);
            pB0 = MFMA32(k0, qf[s], pB0); pB1 = MFMA32(k1, qf[s], pB1); }
        float sa = 0.f;
#pragma unroll
        for (int r = 0; r < 16; ++r) { pA0[r] = ex2(pA0[r]); sa += pA0[r]; }
        const bf16x8 pw0 = pack8f(pA0, 0), pw1 = pack8f(pA0, 8);
        SGB(0x100, 8);
#pragma unroll
        for (int i = 0; i < 8; ++i) { SGB(0x008, 1); SGB(0x002, 5); }
        __builtin_amdgcn_sched_barrier(0);
#pragma unroll
        for (int ks = 0; ks < 2; ++ks)
#pragma unroll
            for (int c = 0; c < 4; ++c) { const s16x4 lo = vtr(vb + (vb0 ^ (c << 6)) + 4096 * ks), h4 = vtr(vb + (vb0 ^ ((c << 6) | 32)) + 2048 + 4096 * ks);
                const bf16x8 vf = (bf16x8){lo[0], lo[1], lo[2], lo[3], h4[0], h4[1], h4[2], h4[3]};
                o[c] = MFMA32(ks ? pw1 : pw0, vf, o[c]); }
        float sb = 0.f;
#pragma unroll
        for (int r = 0; r < 16; ++r) { pA1[r] = ex2(pA1[r]); sb += pA1[r]; }
        lsum += sa + sb;
        const bf16x8 pw2 = pack8f(pA1, 0), pw3 = pack8f(pA1, 8);
        SGB(0x100, 4);
#pragma unroll
        for (int i = 0; i < 6; ++i) { SGB(0x008, 1); SGB(0x100, 2); SGB(0x002, 5); }
        SGB(0x008, 1); SGB(0x002, 5); SGB(0x008, 1); SGB(0x002, 5);
        __builtin_amdgcn_sched_barrier(0);
#pragma unroll
        for (int ks = 2; ks < 4; ++ks)
#pragma unroll
            for (int c = 0; c < 4; ++c) { const s16x4 lo = vtr(vb + (vb0 ^ (c << 6)) + 4096 * ks), h4 = vtr(vb + (vb0 ^ ((c << 6) | 32)) + 2048 + 4096 * ks);
                const bf16x8 vf = (bf16x8){lo[0], lo[1], lo[2], lo[3], h4[0], h4[1], h4[2], h4[3]};
                o[c] = MFMA32(ks == 2 ? pw2 : pw3, vf, o[c]); }
        SGB(0x100, 4);
#pragma unroll
        for (int i = 0; i < 6; ++i) { SGB(0x008, 1); SGB(0x100, 2); }
        SGB(0x008, 1); SGB(0x008, 1);
        __builtin_amdgcn_sched_barrier(0);
        pA0 = pB0; pA1 = pB1;
        k1o = (k1o + 16384) & 65535; k3o = (k3o + 16384) & 65535; v0o = (v0o == 32768) ? 0 : v0o + 16384; v2o = (v2o == 32768) ? 0 : v2o + 16384;
        asm volatile("s_waitcnt vmcnt(4) lgkmcnt(0)" ::: "memory"); __builtin_amdgcn_s_barrier(); asm volatile("" ::: "memory");
    }
    __builtin_amdgcn_s_setprio(0);
#undef AT_DMAK
#undef AT_DMAV
    asm volatile("s_waitcnt vmcnt(0)" ::: "memory"); __syncthreads();
#undef SGB
    lsum += __shfl_xor(lsum, 32);
    LAS float* lb = (LAS float*)(lds + 114688) + wid * 32;
    if (hi == 0) lb[r32] = (mp ? lam : 1.f) / lsum;
    LDS_WAIT(); asm volatile("" ::: "memory");
    float rl[16];
#pragma unroll
    for (int r = 0; r < 16; ++r) rl[r] = lb[crow(r, hi)];
    LAS float* X = (LAS float*)lds + qg * 4096;
    if (mp == 1) {
#pragma unroll
        for (int c = 0; c < 4; ++c)
#pragma unroll
            for (int r = 0; r < 16; ++r) X[crow(r, hi) * 128 + 32 * c + r32] = o[c][r] * rl[r];
    }
    __syncthreads();
    if (mp == 0) {
        float ssq[16];
#pragma unroll
        for (int r = 0; r < 16; ++r) ssq[r] = 0.f;
#pragma unroll
        for (int c = 0; c < 4; ++c)
#pragma unroll
            for (int r = 0; r < 16; ++r) { const float v = o[c][r] * rl[r] - X[crow(r, hi) * 128 + 32 * c + r32]; o[c][r] = v; ssq[r] += v * v; }
#pragma unroll
        for (int r = 0; r < 16; ++r) {
#pragma unroll
            for (int x = 1; x < 32; x <<= 1) ssq[r] += __shfl_xor(ssq[r], x);
            ssq[r] = __builtin_amdgcn_rsqf(ssq[r] * (1.f / 128.f) + 1e-6f) * 0.8f; }
#pragma unroll
        for (int c = 0; c < 4; ++c) { const float sg = subln[32 * c + r32];
#pragma unroll
            for (int r = 0; r < 16; ++r) OA[(tokb + q0 + crow(r, hi)) * 512 + h * 128 + 32 * c + r32] = f2bf(o[c][r] * ssq[r] * sg); }
    }
    __syncthreads();
}

__device__ __forceinline__ void ret_state_task(LAS uchar* wl, int task, const bf16* KR, const bf16* VR, bf16* RT, const float* dec_f, const float* dec_b, int lane) {
    const int dt = task & 3, et = (task >> 2) & 7, dir = (task >> 5) & 1, h = (task >> 6) & 3, b = task >> 8;
    const float x = dir ? dec_b[h] : dec_f[h];
    const float lg2 = -log1pf(expf(-x)) * LOG2E, decay = ex2(128.f * lg2);
    f32x4 st = (f32x4){0.f, 0.f, 0.f, 0.f};
    const int g = lane >> 4, li = lane & 15, q = li >> 2, p = li & 3, hc = lane & 1;
    u32x4 vvA[4], kkA[4], vvB[4], kkB[4];
#define RS_LOAD(VV, KK, nn) do { const size_t t0_ = (size_t)b * SEQ + (nn) * 128; _Pragma("unroll") for (int i = 0; i < 4; ++i) { const int row = 32 * i + (lane >> 1); \
        VV[i] = *(const u32x4*)(VR + (t0_ + row) * 512 + 128 * h + 16 * et + 8 * hc); KK[i] = *(const u32x4*)(KR + (t0_ + row) * 256 + 64 * h + 16 * dt + 8 * hc); } } while (0)
#define RS_STEP(step, VV, KK) do { \
        const int n = dir ? 15 - (step) : (step); \
        bf16* rt = RT + ((((size_t)(b * 4 + h) * 2 + dir) * 16 + n) * 128 + 16 * et) * 64 + 16 * dt; \
        _Pragma("unroll") for (int r = 0; r < 4; ++r) rt[(4 * g + r) * 64 + li] = f2bf(st[r]); \
        if ((step) < 15) { \
            _Pragma("unroll") for (int i = 0; i < 4; ++i) { const int row = 32 * i + (lane >> 1); \
                const float z = dir ? ex2((float)row * lg2) : ex2((float)(127 - row) * lg2); \
                u32x4 ks; ks.x = cvtpk(pg8::bflo(KK[i].x) * z, pg8::bfhi(KK[i].x) * z); ks.y = cvtpk(pg8::bflo(KK[i].y) * z, pg8::bfhi(KK[i].y) * z); ks.z = cvtpk(pg8::bflo(KK[i].z) * z, pg8::bfhi(KK[i].z) * z); ks.w = cvtpk(pg8::bflo(KK[i].w) * z, pg8::bfhi(KK[i].w) * z); \
                *(LAS u32x4*)(wl + row * 32 + 16 * hc) = VV[i]; *(LAS u32x4*)(wl + 4096 + row * 32 + 16 * hc) = ks; } \
            if ((step) + 2 < 15) RS_LOAD(VV, KK, dir ? 13 - (step) : (step) + 2); \
            f32x4 acc = (f32x4){0.f, 0.f, 0.f, 0.f}; \
            _Pragma("unroll") for (int s_ = 0; s_ < 4; ++s_) { const int ra = 32 * s_ + 8 * g + q; \
                const s16x4 a0 = vtr(wl + ra * 32 + 8 * p), a1 = vtr(wl + (ra + 4) * 32 + 8 * p), b0 = vtr(wl + 4096 + ra * 32 + 8 * p), b1 = vtr(wl + 4096 + (ra + 4) * 32 + 8 * p); \
                const bf16x8 A = (bf16x8){a0[0], a0[1], a0[2], a0[3], a1[0], a1[1], a1[2], a1[3]}, B = (bf16x8){b0[0], b0[1], b0[2], b0[3], b1[0], b1[1], b1[2], b1[3]}; \
                acc = __builtin_amdgcn_mfma_f32_16x16x32_bf16(A, B, acc, 0, 0, 0); } \
            st = st * decay + acc; \
            LDS_WAIT(); asm volatile("" ::: "memory"); } } while (0)
    RS_LOAD(vvA, kkA, dir ? 15 : 0); RS_LOAD(vvB, kkB, dir ? 14 : 1);
#pragma unroll 1
    for (int step = 0; step < 16; step += 2) { RS_STEP(step, vvA, kkA); RS_STEP(step + 1, vvB, kkB); }
#undef RS_LOAD
#undef RS_STEP
}

__device__ __forceinline__ void ret_unit(LAS uchar* lds, int b, int h, int n, const bf16* QR, const bf16* KR, bf16* VRY, const bf16* RT, const bf16* RG, const float* ret_norm, float lgf2, float lgb2, bool nostore) {
    int tid = threadIdx.x; asm volatile("" : "+v"(tid));
    const int lane = tid & 63, wid = __builtin_amdgcn_readfirstlane(tid >> 6), ib = wid & 3, eh = wid >> 2, r32 = lane & 31, hi = lane >> 5;
    const size_t tok0 = (size_t)b * SEQ + n * 128;
    bf16x8 rtf[2][4], rtb[2][4];
#pragma unroll
    for (int cc = 0; cc < 2; ++cc) {
        const bf16* rF = RT + ((((size_t)(b * 4 + h) * 2 + 0) * 16 + n) * 128 + 64 * eh + 32 * cc + r32) * 64 + 8 * hi;
        const bf16* rB = rF + (size_t)16 * 128 * 64;
#pragma unroll
        for (int s = 0; s < 4; ++s) { rtf[cc][s] = *(const bf16x8*)(rF + 16 * s); rtb[cc][s] = *(const bf16x8*)(rB + 16 * s); } }
    { u32x4 tk[2], tv[4];
#pragma unroll
      for (int i = 0; i < 2; ++i) { const int pc = tid + 512 * i, row = pc >> 3, ch = pc & 7; tk[i] = *(const u32x4*)(KR + (tok0 + row) * 256 + 64 * h + 8 * ch); }
#pragma unroll
      for (int i = 0; i < 4; ++i) { const int pc = tid + 512 * i, row = pc >> 4, ch = pc & 15; tv[i] = *(const u32x4*)(VRY + (tok0 + row) * 512 + 128 * h + 8 * ch); }
#pragma unroll
      for (int i = 0; i < 2; ++i) { const int pc = tid + 512 * i, row = pc >> 3, ch = pc & 7; *(LAS u32x4*)(lds + koff(row, ch)) = tk[i]; }
#pragma unroll
      for (int i = 0; i < 4; ++i) { const int pc = tid + 512 * i, row = pc >> 4, ch = pc & 15; *(LAS u32x4*)(lds + 16384 + voff(row, ch)) = tv[i]; } }
    bf16x8 qf[4];
    { const bf16* qp = QR + (tok0 + 32 * ib + r32) * 256 + 64 * h + 8 * hi;
#pragma unroll
      for (int s = 0; s < 4; ++s) qf[s] = *(const bf16x8*)(qp + 16 * s); }
    __syncthreads();
    f32x16 y[2];
#pragma unroll
    for (int cc = 0; cc < 2; ++cc) {
        f32x16 af, ab;
#pragma unroll
        for (int r = 0; r < 16; ++r) { af[r] = 0.f; ab[r] = 0.f; }
#pragma unroll
        for (int s = 0; s < 4; ++s) { af = MFMA32(qf[s], rtf[cc][s], af); ab = MFMA32(qf[s], rtb[cc][s], ab); }
#pragma unroll
        for (int r = 0; r < 16; ++r) { const int i = 32 * ib + crow(r, hi); y[cc][r] = ex2((float)(i + 1) * lgf2) * af[r] + ex2((float)(128 - i) * lgb2) * ab[r]; }
    }
    LAS const uchar* vb = lds + 16384;
#pragma unroll
    for (int jb = 0; jb < 4; ++jb) {
        f32x16 st;
#pragma unroll
        for (int r = 0; r < 16; ++r) st[r] = 0.f;
#pragma unroll
        for (int s = 0; s < 4; ++s) { const bf16x8 kf = *(LAS const bf16x8*)(lds + koff(32 * jb + r32, 2 * s + hi)); st = MFMA32(kf, qf[s], st); }
#pragma unroll
        for (int r = 0; r < 16; ++r) { const int df = (32 * ib + r32) - (32 * jb + crow(r, hi));
            const float fac = df > 0 ? ex2((float)df * lgf2) : (df < 0 ? ex2((float)(-df) * lgb2) : 2.0f); st[r] *= fac; }
        const bf16x8 pw0 = pack8f(st, 0), pw1 = pack8f(st, 8);
#pragma unroll
        for (int cc = 0; cc < 2; ++cc) { y[cc] = MFMA32(pw0, vfrag(vb, 2 * jb, 2 * eh + cc, lane), y[cc]); y[cc] = MFMA32(pw1, vfrag(vb, 2 * jb + 1, 2 * eh + cc, lane), y[cc]); }
    }
    float ssq[16];
#pragma unroll
    for (int r = 0; r < 16; ++r) { float v = y[0][r] * y[0][r] + y[1][r] * y[1][r];
#pragma unroll
        for (int x = 1; x < 32; x <<= 1) v += __shfl_xor(v, x);
        ssq[r] = v; }
    unsigned short rgv[2][16];
#pragma unroll
    for (int cc = 0; cc < 2; ++cc)
#pragma unroll
        for (int r = 0; r < 16; ++r) rgv[cc][r] = RG[(tok0 + 32 * ib + crow(r, hi)) * 512 + 128 * h + 64 * eh + 32 * cc + r32];
    LAS float* sbuf = (LAS float*)(lds + 49152);
    if (r32 == 0) {
#pragma unroll
        for (int r = 0; r < 16; ++r) sbuf[wid * 32 + crow(r, hi)] = ssq[r]; }
    __syncthreads();
#pragma unroll
    for (int r = 0; r < 16; ++r) ssq[r] = __builtin_amdgcn_rsqf((ssq[r] + sbuf[(wid ^ 4) * 32 + crow(r, hi)]) * (1.f / 128.f) + 1e-6f);
#pragma unroll
    for (int cc = 0; cc < 2; ++cc) { const int e = 64 * eh + 32 * cc + r32; const float gn = ret_norm[e];
#pragma unroll
        for (int r = 0; r < 16; ++r) { const size_t off = (tok0 + 32 * ib + crow(r, hi)) * 512 + 128 * h + e; const unsigned short ov = f2bf(y[cc][r] * ssq[r] * gn * bf2f(rgv[cc][r])); if (!nostore) VRY[off] = ov; } }
    __syncthreads();
}
#define RLX_AGENT __ATOMIC_RELAXED, __HIP_MEMORY_SCOPE_AGENT
#define XB_TMO      128
#define XB_XCNT(j)  (256  + 64 * (j))
#define XB_XSUB(j)  (1280 + 64 * (j))
#define XB_XGEN(j)  (2304 + 64 * (j))
#define XB_TOP      3328
#define XB_TOPGEN   3392
#define XCD_BAR_WORDS 3456
#define XB_SPIN_CAP (1u << 18)

__device__ __forceinline__ unsigned xb_ld(unsigned* p)              { return __hip_atomic_load(p, __ATOMIC_RELAXED, __HIP_MEMORY_SCOPE_AGENT); }
__device__ __forceinline__ unsigned xb_add(unsigned* p, unsigned v) { return __hip_atomic_fetch_add(p, v, __ATOMIC_RELAXED, __HIP_MEMORY_SCOPE_AGENT); }
__device__ __forceinline__ unsigned xb_xcc_id() { return (unsigned)__builtin_amdgcn_s_getreg((3 << 11) | 20) & 0xFu; }
#define XB_SPIN(cond, bar) do { unsigned _sp = 0; while (cond) { __builtin_amdgcn_s_sleep(1); \
    if ((++_sp & 255u) == 0u) { if (xb_ld(&(bar)[XB_TMO])) break; if (_sp > XB_SPIN_CAP) { atomicAdd(&(bar)[XB_TMO], 1u); break; } } } } while (0)

struct XcdBarrier {
    unsigned* bar; unsigned x;
    volatile LAS unsigned* st;
};

__device__ __forceinline__ XcdBarrier xcd_barrier_post(unsigned* bar, volatile LAS unsigned* st) {
    XcdBarrier b; b.bar = bar; b.x = xb_xcc_id(); b.st = st;
    if (threadIdx.x == 0) (void)xb_add(&bar[XB_XCNT(b.x)], 1u);
    return b;
}
__device__ __forceinline__ void xcd_barrier_complete(unsigned* bar, unsigned x, unsigned& nloc, unsigned& nx) {
    const unsigned G = gridDim.x * gridDim.y * gridDim.z;
    unsigned sum, cnt, mine, sp = 0u;
    for (;;) {
        sum = 0u; cnt = 0u; mine = 0u;
#pragma unroll
        for (unsigned j = 0; j < 16; ++j) { const unsigned c = xb_ld(&bar[XB_XCNT(j)]); sum += c; cnt += (c > 0u) ? 1u : 0u; mine = (j == x) ? c : mine; }
        if (sum == G) break;
        __builtin_amdgcn_s_sleep(1);
        if ((++sp & 255u) == 0u) { if (xb_ld(&bar[XB_TMO])) break; if (sp > XB_SPIN_CAP) { atomicAdd(&bar[XB_TMO], 1u); break; } }
    }
    nloc = mine > 0u ? mine : 1u; nx = cnt > 0u ? cnt : 1u;
}

__device__ __forceinline__ void xcd_barrier(const XcdBarrier& b) {
    asm volatile("s_waitcnt vmcnt(0)" ::: "memory");
    __syncthreads();
    if (threadIdx.x == 0) {
        unsigned* bar = b.bar;
        __builtin_amdgcn_s_waitcnt(0);
        unsigned nloc = b.st[0], nx = b.st[1];
        if (nloc == 0u) { xcd_barrier_complete(bar, b.x, nloc, nx); b.st[0] = nloc; b.st[1] = nx; }
        const unsigned old = xb_add(&bar[XB_XSUB(b.x)], 1u);
        const unsigned gen = old / nloc;
        if (old + 1u == (gen + 1u) * nloc) {
            __builtin_amdgcn_fence(__ATOMIC_RELEASE, "agent");
            asm volatile("s_waitcnt vmcnt(0)" ::: "memory");
            const unsigned og = xb_add(&bar[XB_TOP], 1u);
            const unsigned tg = og / nx;
            if (og + 1u == (tg + 1u) * nx) xb_add(&bar[XB_TOPGEN], 1u);
            else XB_SPIN(xb_ld(&bar[XB_TOPGEN]) == tg, bar);
            __builtin_amdgcn_fence(__ATOMIC_ACQUIRE, "agent");
            xb_add(&bar[XB_XGEN(b.x)], 1u);
            asm volatile("s_waitcnt vmcnt(0)" ::: "memory");
        } else {
            XB_SPIN(xb_ld(&bar[XB_XGEN(b.x)]) == gen, bar);
            __builtin_amdgcn_fence(__ATOMIC_ACQUIRE, "agent");
            asm volatile("s_waitcnt vmcnt(0)" ::: "memory");
        }
    }
    __syncthreads();
}

__device__ __forceinline__ unsigned xcd_barrier_arrive(const XcdBarrier& b) {
    asm volatile("s_waitcnt vmcnt(0)" ::: "memory");
    __syncthreads();
    unsigned gen = 0u;
    if (threadIdx.x == 0) {
        unsigned* bar = b.bar;
        __builtin_amdgcn_s_waitcnt(0);
        unsigned nloc = b.st[0], nx = b.st[1];
        if (nloc == 0u) { xcd_barrier_complete(bar, b.x, nloc, nx); b.st[0] = nloc; b.st[1] = nx; }
        const unsigned old = xb_add(&bar[XB_XSUB(b.x)], 1u);
        gen = old / nloc;
        if (old + 1u == (gen + 1u) * nloc) {
            __builtin_amdgcn_fence(__ATOMIC_RELEASE, "agent");
            asm volatile("s_waitcnt vmcnt(0)" ::: "memory");
            const unsigned og = xb_add(&bar[XB_TOP], 1u);
            const unsigned tg = og / nx;
            if (og + 1u == (tg + 1u) * nx) xb_add(&bar[XB_TOPGEN], 1u);
            else XB_SPIN(xb_ld(&bar[XB_TOPGEN]) == tg, bar);
            __builtin_amdgcn_fence(__ATOMIC_ACQUIRE, "agent");
            xb_add(&bar[XB_XGEN(b.x)], 1u);
            asm volatile("s_waitcnt vmcnt(0)" ::: "memory");
        }
    }
    return gen;
}
__device__ __forceinline__ void xcd_barrier_wait(const XcdBarrier& b, unsigned gen) {
    if (threadIdx.x == 0) {
        XB_SPIN(xb_ld(&b.bar[XB_XGEN(b.x)]) == gen, b.bar);
        __builtin_amdgcn_fence(__ATOMIC_ACQUIRE, "agent");
        asm volatile("s_waitcnt vmcnt(0)" ::: "memory");
    }
    __syncthreads();
}

#ifndef MK_N_LAUNCHES
#define MK_N_LAUNCHES 1
#endif
constexpr int N_PHASES = 12;
__global__ void __launch_bounds__(NWAVES * 64, 2) mk_fwd(Args args) {
    extern __shared__ __attribute__((aligned(16))) unsigned char lds_raw[];
    LAS uchar* lds = (LAS uchar*)lds_raw;
    cg::grid_group grid = cg::this_grid();
    const int tid = threadIdx.x, lane = tid & 63, wave = __builtin_amdgcn_readfirstlane(tid >> 6);
    const int G = gridDim.x, bx = blockIdx.x, vcu = (G % 8 == 0) ? (bx % 8) * (G / 8) + bx / 8 : bx;
    const int gw = vcu * NWAVES + wave, NGW = G * NWAVES;
    uchar* ws = args.ws;
    volatile LAS unsigned* MISC = (volatile LAS unsigned*)(lds + RING_BYTES + 320);
    if (tid < 64) ((LAS unsigned*)(lds + RING_BYTES))[tid * 2] = 0u, ((LAS unsigned*)(lds + RING_BYTES))[tid * 2 + 1] = 0u;
    __syncthreads();
    if (args.ph_lo == 0x7fffffff) grid.sync();
    XcdBarrier bar = xcd_barrier_post((unsigned*)(ws + WS_CTL + 512 * 1024), MISC + 8);
#define x (args.in[0])
#define cvec (args.in[1])
#define positions ((const int*)args.in[2])
#define w_ada (args.in[3])
#define b_ada (args.in[4])
#define out (args.out)
#define mod ((float*)(ws + WS_MOD))
#define W13A ((bf16*)(ws + WS_W13A))
#define W2A ((bf16*)(ws + WS_W2A))
#define WIN ((bf16*)(ws + WS_WIN))
#define WA ((bf16*)(ws + WS_WA))
#define WR ((bf16*)(ws + WS_WR))
#define WO ((bf16*)(ws + WS_WO))
#define W13B ((bf16*)(ws + WS_W13B))
#define W2B ((bf16*)(ws + WS_W2B))
#define cosA ((float*)(ws + WS_TAB))
#define sinA ((float*)(ws + WS_TAB + 2 * MiB))
#define cosR ((float*)(ws + WS_TAB + 4 * MiB))
#define sinR ((float*)(ws + WS_TAB + 6 * MiB))
#define H ((bf16*)(ws + WS_H))
#define RT ((bf16*)(ws + WS_H))
#define U ((bf16*)(ws + WS_Z))
#define QA ((bf16*)(ws + WS_QA))
#define KA ((bf16*)(ws + WS_KA))
#define VA ((bf16*)(ws + WS_VA))
#define QR ((bf16*)(ws + WS_QR))
#define KR ((bf16*)(ws + WS_KR))
#define VR ((bf16*)(ws + WS_VR))
#define RG ((bf16*)(ws + WS_RG))
#define GA ((bf16*)(ws + WS_GA))
#define GR ((bf16*)(ws + WS_GR))
#define T ((bf16*)(ws + WS_T))
#define OA ((bf16*)(ws + WS_H + 16 * MiB))
#define RSS ((float*)(ws + WS_CTL + 768 * 1024))
#define X1B ((bf16*)out)
#define X2B ((bf16*)(ws + WS_GA))
#define BIAS1 ((float*)(ws + 250 * MiB))
#define BIAS2 ((float*)(ws + 250 * MiB + 256 * 1024))
#define BIAS3 ((float*)(ws + 250 * MiB + 512 * 1024))
    const int lo = args.ph_lo, hi_ph = args.ph_hi;
#ifndef PHMASK
#define PHMASK 0xffff
#endif
#define IN(k) (((PHMASK >> (k)) & 1) && lo <= (k) && (k) < hi_ph)
#ifndef DUPMASK
#define DUPMASK 0
#endif
#define REPS(k) _Pragma("unroll") for (int rep_ = 0; rep_ < (((DUPMASK >> (k)) & 1) ? 2 : 1); ++rep_)
#ifndef TMASK
#define TMASK 0
#endif
    unsigned long long tacc_ = 0ull, tb_ = 0ull;
#define TB(k) do { if ((TMASK >> (k)) & 1) tb_ = __builtin_amdgcn_s_memrealtime(); } while (0)
#define TE(k) do { if ((TMASK >> (k)) & 1) tacc_ += __builtin_amdgcn_s_memrealtime() - tb_; } while (0)
#define SEAM(k) do { if (IN(k) && hi_ph > (k) + 1) { TB(13); xcd_barrier(bar); TE(13); } } while (0)

    TB(0);
    if (IN(0)) REPS(0) {
        LAS float* scr = (LAS float*)(lds + wave * 16384);
        constexpr int I13 = 16 * 176, I2 = 44 * 32, IIN = 16 * 160, IBR = 8 * 32, IO = 16 * 32;
        for (int task = bx * NWAVES + wave; task < 36 * 32; task += NGW) {
            const int cgp = task % 36, ks = task / 36, n = 256 * cgp + 4 * lane;
            f32x4 a[8];
#pragma unroll
            for (int b = 0; b < 8; ++b) a[b] = (f32x4){0.f, 0.f, 0.f, 0.f};
#pragma unroll 1
            for (int k4 = 0; k4 < 1; ++k4) {
                float sv[8];
#pragma unroll
                for (int b = 0; b < 8; ++b) sv[b] = pg8::silu(cvec[b * D + 32 * ks + 32 * k4 + (lane & 31)]);
#pragma unroll 16
                for (int kk = 0; kk < 32; ++kk) { const f32x4 w = __builtin_nontemporal_load((const f32x4*)(w_ada + (size_t)(32 * ks + 32 * k4 + kk) * NMOD + n));
#pragma unroll
                    for (int b = 0; b < 8; ++b) a[b] += w * __uint_as_float(__builtin_amdgcn_readlane(__float_as_uint(sv[b]), kk)); }
            }
            f32x4 bias = (f32x4){0.f, 0.f, 0.f, 0.f}; if (ks == 0) bias = *(const f32x4*)(b_ada + n);
#pragma unroll
            for (int b = 0; b < 8; ++b) { float* mp_ = (rep_ == 0 ? mod : (float*)(ws + WS_CTL + 640 * 1024)) + (size_t)b * NMOD + n; atomicAdd(mp_ + 0, a[b][0] + bias[0]); atomicAdd(mp_ + 1, a[b][1] + bias[1]); atomicAdd(mp_ + 2, a[b][2] + bias[2]); atomicAdd(mp_ + 3, a[b][3] + bias[3]); }
        }
        for (int it = gw; it < I13 + I2; it += NGW) {
            int r = it;
            if (r < I13) { tr_w13(args.in[6], args.in[7], W13A, r, scr, lane); continue; } r -= I13;
            tr_plain(args.in[8], FF, D, W2A, r, scr, lane);
        }
        for (int idx = (vcu * NWAVES * 64 + tid); idx < M * 32; idx += G * NWAVES * 64) {
            const int tok = idx >> 5, i = idx & 31; const double pos = (double)positions[tok];
            const double TWO_PI_HI = 6.283185307179586, TWO_PI_LO = 2.4492935982947064e-16, INV2PI = 0.15915494309189535;
            { const double inv = exp2(-13.287712379549449 * (double)i / 32.0); const double a = pos * inv, k = rint(a * INV2PI); double r = fma(-k, TWO_PI_HI, a); r = fma(-k, TWO_PI_LO, r); const float rf = (float)r; cosA[idx] = cosf(rf); sinA[idx] = sinf(rf); }
            { const double inv = exp2(-13.287712379549449 * (double)i / 31.0); const double a = pos * inv, k = rint(a * INV2PI); double r = fma(-k, TWO_PI_HI, a); r = fma(-k, TWO_PI_LO, r); const float rf = (float)r; cosR[idx] = cosf(rf); sinR[idx] = sinf(rf); }
        }
    }
    TE(0);
    SEAM(0);
#ifdef XSYNC
    for (int i_ = 0; i_ < XSYNC; ++i_) xcd_barrier(bar);
#endif
    TB(1);
    if (IN(1)) REPS(1) { norm_phase(x, args.in[5], mod + 1 * D, H, RSS, gw, NGW, lane);
        bias_rows(W13A, 2 * FF, mod + 0 * D, BIAS1, gw, NGW, lane); }
    TE(1);
    SEAM(1);
    TB(2);
    if (IN(2)) REPS(2) { pg8::Gemm g{H, W13A, M, 2 * FF, D}; pg8::StaticOrder S; S.init(M, 2 * FF, G, bx); pg8::EpiUp E{U, FF, RSS, BIAS1};
        pg8::gemm_phase<pg8::EpiUp, pg8::StaticOrder, true, true>(lds, g, S, E);
        if (rep_ == 0) {
            constexpr int I13 = 16 * 176, I2 = 44 * 32, IIN = 16 * 160, IBR = 8 * 32, IO = 16 * 32, NLATE = IIN + 2 * IBR + IO + I13 + I2;
            const int rem = ((M / 256) * (2 * FF / 256)) % G; const bool all = rem == 0;
            if (all || bx >= rem) {
                LAS float* scr = (LAS float*)(lds + wave * 16384);
                const int w0_ = (all ? bx : bx - rem) * NWAVES + wave, nw_ = (all ? G : G - rem) * NWAVES;
                for (int it = w0_; it < NLATE; it += nw_) {
                    int r = it;
                    if (r < IIN) { tr_win(args.in[10], WIN, r, scr, lane); continue; } r -= IIN;
                    if (r < IBR) { tr_plain(args.in[22], 512, D, WA, r, scr, lane); continue; } r -= IBR;
                    if (r < IBR) { tr_plain(args.in[23], 512, D, WR, r, scr, lane); continue; } r -= IBR;
                    if (r < IO) { tr_plain(args.in[24], D, D, WO, r, scr, lane); continue; } r -= IO;
                    if (r < I13) { tr_w13(args.in[26], args.in[27], W13B, r, scr, lane); continue; } r -= I13;
                    tr_plain(args.in[28], FF, D, W2B, r, scr, lane);
                }
            }
        } }
    TE(2);
    SEAM(2);
    TB(3);
    if (IN(3)) REPS(3) { pg8::Gemm g{U, W2A, M, D, FF}; pg8::StaticOrder S; S.init(M, D, G, bx); pg8::EpiRes<false, true, true, 1> E{x, X1B, mod + 2 * D, H, args.in[9], mod + 4 * D, RSS + M};
        pg8::gemm_phase<pg8::EpiRes<false, true, true, 1>, pg8::StaticOrder, true, true>(lds, g, S, E);
        bias_rows(WIN, NIN, mod + 3 * D, BIAS2, gw, NGW, lane); bias_rows(W13B, 2 * FF, mod + 6 * D, BIAS3, gw, NGW, lane); }
    TE(3);
    SEAM(3);
    TB(5);
    if (IN(5)) REPS(5) { pg8::Gemm g{H, WIN, M, NIN, D}; pg8::StaticOrder S; S.init(M, NIN, G, bx);
        pg8::EpiIn E{ws, args.in[12], args.in[13], args.in[11], QSCALE, RSS + M, BIAS2};
        static_assert(pg8::EpiIn::oTAB == WS_TAB && pg8::EpiIn::oZ == WS_Z && pg8::EpiIn::oGR == WS_GR && pg8::EpiIn::oVR == WS_VR, "EpiIn workspace map");
        pg8::gemm_phase<pg8::EpiIn, pg8::StaticOrder, true, true>(lds, g, S, E); }
    TE(5);
    SEAM(5);
    TB(6);
    if (IN(6)) REPS(6) { for (int task = gw; task < 2048; task += NGW) ret_state_task(lds + wave * 8192, task, KR, VR, RT, args.in[19], args.in[20], lane); }
    TE(6);
    const bool split6 = IN(6) && hi_ph > 7;
    unsigned gen6 = 0u; if (split6) { TB(13); gen6 = xcd_barrier_arrive(bar); TE(13); }
    TB(7);
    if (IN(7)) {
        const float l1 = wave_sum(args.in[14][lane] * args.in[15][lane]), l2 = wave_sum(args.in[16][lane] * args.in[17][lane]);
        const float lam = expf(l1) - expf(l2) + 0.2f;
        float mq = fabsf(args.in[12][lane]), mk = fabsf(args.in[13][lane]);
#pragma unroll
        for (int o = 1; o < 64; o <<= 1) { mq = fmaxf(mq, __shfl_xor(mq, o)); mk = fmaxf(mk, __shfl_xor(mk, o)); }
        const float negC = -(8.0f * LOG2E * mq * mk);
#ifndef NO_ATT
        _Pragma("unroll 1") for (int rep_ = 0; rep_ < (((DUPMASK >> 7) & 1) ? 2 : 1); ++rep_) for (int u = vcu; u < 512; u += G) attn_unit(lds, u >> 6, (u >> 4) & 3, u & 15, QA, KA, VA, OA, negC, lam, args.in[18]);
#endif
#ifndef NO_RET
        if (split6) xcd_barrier_wait(bar, gen6);
        TB(14);
        for (int u = vcu; u < 512; u += G) { const int b = u >> 6, h = (u >> 4) & 3;
            const float lgf2 = -log1pf(expf(-args.in[19][h])) * LOG2E, lgb2 = -log1pf(expf(-args.in[20][h])) * LOG2E;
#ifdef RETDUP
            ret_unit(lds, b, h, u & 15, QR, KR, VR, RT, RG, args.in[21], lgf2, lgb2, args.ph_lo != 12345);
#endif
            ret_unit(lds, b, h, u & 15, QR, KR, VR, RT, RG, args.in[21], lgf2, lgb2, false); }
#endif
        TE(14);
    }
    TE(7);
    SEAM(7);
    TB(8);
    if (IN(8)) REPS(8) {
        { pg8::Gemm g{OA, WA, M, D, 512}; pg8::StaticOrder S; S.init(M, D, G, bx); pg8::EpiBr<0> E{T, GA}; pg8::gemm_phase<pg8::EpiBr<0>, pg8::StaticOrder, true, true>(lds, g, S, E); }
        { pg8::Gemm g{VR, WR, M, D, 512}; pg8::StaticOrder S; S.init(M, D, G, bx); pg8::EpiBr<1> E{T, GR}; pg8::gemm_phase<pg8::EpiBr<1>, pg8::StaticOrder, true, true>(lds, g, S, E); }
    }
    TE(8);
    SEAM(8);
    TB(9);
    if (IN(9)) { pg8::Gemm g{T, WO, M, D, D}; pg8::StaticOrder S; S.init(M, D, G, bx); pg8::EpiRes<true, true, true, 2> E{X1B, X2B, mod + 5 * D, H, args.in[25], mod + 7 * D, RSS + 2 * M};
        pg8::gemm_phase<pg8::EpiRes<true, true, true, 2>, pg8::StaticOrder, true, true>(lds, g, S, E); }
    TE(9);
    SEAM(9);
    TB(11);
    if (IN(11)) { pg8::Gemm g{H, W13B, M, 2 * FF, D}; pg8::StaticOrder S; S.init(M, 2 * FF, G, bx); pg8::EpiUp E{U, FF, RSS + 2 * M, BIAS3};
        pg8::gemm_phase<pg8::EpiUp, pg8::StaticOrder, true, true>(lds, g, S, E); }
    TE(11);
    SEAM(11);
    TB(12);
    if (IN(12)) { pg8::Gemm g{U, W2B, M, D, FF}; pg8::StaticOrder S; S.init(M, D, G, bx); pg8::EpiRes<true, false, false, 1> E{X2B, out, mod + 8 * D, nullptr, nullptr, nullptr, nullptr};
        pg8::gemm_phase<pg8::EpiRes<true, false, false, 1>, pg8::StaticOrder, true, true>(lds, g, S, E); }
    TE(12);
    if (TMASK && bx == 0 && tid == 0) { const unsigned long long t0_ = __builtin_amdgcn_s_memrealtime(); while (__builtin_amdgcn_s_memrealtime() - t0_ < 4ull * tacc_) __builtin_amdgcn_s_sleep(8); }
#undef IN
#undef SEAM
}

#undef x
#undef cvec
#undef positions
#undef w_ada
#undef b_ada
#undef out
#undef mod
#undef W13A
#undef W2A
#undef WIN
#undef WA
#undef WR
#undef WO
#undef W13B
#undef W2B
#undef cosA
#undef sinA
#undef cosR
#undef sinR
#undef H
#undef RT
#undef U
#undef QA
#undef KA
#undef VA
#undef QR
#undef KR
#undef VR
#undef RG
#undef GA
#undef GR
#undef T
#undef OA
#undef RSS
#undef X1B
#undef X2B
#undef BIAS1
#undef BIAS2
#undef BIAS3
extern "C" void kernel_launch(void* const* d_in, const int* in_sizes, int n_in, void* d_out, int out_size, void* d_ws, size_t ws_size, hipStream_t stream) {
    static int grid = 0;
    if (grid == 0) {
        if (n_in != 29 || out_size != M * D || ws_size < WS_END) { fprintf(stderr, "kernel_launch: unexpected shapes (n_in %d out %d ws %zu)\n", n_in, out_size, ws_size); grid = -1; return; }
        int dev = 0, cus = 0, per_cu = 0;
        (void)hipGetDevice(&dev); (void)hipDeviceGetAttribute(&cus, hipDeviceAttributeMultiprocessorCount, dev);
        if (hipFuncSetAttribute((const void*)mk_fwd, hipFuncAttributeMaxDynamicSharedMemorySize, LDS_BYTES) != hipSuccess) { fprintf(stderr, "kernel_launch: hipFuncSetAttribute failed\n"); grid = -1; return; }
        if (hipOccupancyMaxActiveBlocksPerMultiprocessor(&per_cu, (const void*)mk_fwd, NWAVES * 64, LDS_BYTES) != hipSuccess || per_cu < 1) { fprintf(stderr, "kernel_launch: occupancy query says %d\n", per_cu); per_cu = 1; }
        (void)hipGetLastError();
        grid = cus * 1;
        if (grid <= 0) grid = 256;
    }
    if (grid < 0) return;
    (void)hipMemsetAsync((char*)d_ws + WS_CTL, 0, CTL_ZERO_BYTES, stream);
    Args a{};
    for (int i = 0; i < 29; ++i) a.in[i] = (const float*)d_in[i];
    a.out = (float*)d_out; a.ws = (unsigned char*)d_ws;
#if MK_N_LAUNCHES == 1
    a.ph_lo = 0; a.ph_hi = N_PHASES + 1;
    void* kargs[] = {&a};
    hipError_t e = hipLaunchCooperativeKernel((const void*)mk_fwd, dim3(grid), dim3(NWAVES * 64), kargs, LDS_BYTES, stream);
    if (e != hipSuccess) fprintf(stderr, "kernel_launch: cooperative launch failed: %s (grid %d)\n", hipGetErrorString(e), grid);
#else
    for (int p = 0; p <= N_PHASES; ++p) { a.ph_lo = p; a.ph_hi = p + 1; hipLaunchKernelGGL(mk_fwd, dim3(grid), dim3(NWAVES * 64), LDS_BYTES, stream, a); }
#endif
}
```

```cpp
#include <hip/hip_runtime.h>
#include <hip/hip_cooperative_groups.h>
#include <cstdio>
#include <cstdint>
#include <cmath>
namespace cg = cooperative_groups;


namespace pg8 {
#define PG8_LAS __attribute__((address_space(3)))
typedef unsigned short bf16_t;
typedef short bf16x8 __attribute__((ext_vector_type(8)));
typedef float f32x4 __attribute__((ext_vector_type(4)));
typedef unsigned u32x4 __attribute__((ext_vector_type(4)));
constexpr int BM = 256, BK = 64, HALF = 128, HTB = HALF * BK * 2  , STAGE_BYTES = 8 * HTB, NXCD = 8, WGM = 8;

__host__ __device__ __forceinline__ int lds_byte(int r, int c) { const int st = (r >> 4) * 2 + (c >> 5), rr = r & 15, cc = c & 31, ob = rr * 64 + cc * 2; return st * 1024 + (ob ^ (((ob >> 9) & 1) << 5)); }
__host__ __device__ __forceinline__ void stage_rc(int b, int& R, int& C) { const int st = b / 1024, sb = b % 1024, swz = sb ^ (((sb >> 9) & 1) << 5); R = (st >> 1) * 16 + swz / 64; C = (st & 1) * 32 + (swz % 64) / 2; }
__host__ __device__ __forceinline__ int perm32(int rho) { const int n = rho >> 4, i = rho & 15; return 8 * (i >> 2) + 4 * n + (i & 3); }

struct Unit { int pm, pn; };
struct Gemm { const bf16_t* A; const bf16_t* Bt; int M, N, K; };

struct StaticOrder {
    int nM, nN, nwg, G, c;
    __host__ __device__ void init(int M, int N, int G_, int c_) { nM = M / BM; nN = N / BM; nwg = nM * nN; G = G_; c = c_; }
    __host__ __device__ bool next(int i, Unit& u) const {
        const long L = (long)i * G + c; if (L >= nwg) return false;
        int wgid = (int)L; { const int q = nwg / NXCD, r = nwg % NXCD, xcd = wgid % NXCD, off = wgid / NXCD; wgid = (xcd < r ? xcd * (q + 1) : r * (q + 1) + (xcd - r) * q) + off; }
        const int nig = WGM * nN, gid = wgid / nig, fm = gid * WGM, gsz = (nM - fm) < WGM ? (nM - fm) : WGM;
        u.pm = fm + ((wgid % nig) % gsz); u.pn = (wgid % nig) / gsz; return true;
    }
    __device__ __forceinline__ void a_ready(const Unit&) const {}
    __device__ __forceinline__ void done(const Unit&) const {}
};

__device__ __forceinline__ unsigned cvt_pk_bf16(float lo, float hi) { unsigned r; asm volatile("v_cvt_pk_bf16_f32 %0, %1, %2" : "=v"(r) : "v"(lo), "v"(hi)); return r; }
typedef float f32x2 __attribute__((ext_vector_type(2)));
__device__ __forceinline__ float bflo(unsigned w) { return __uint_as_float(w << 16); }
__device__ __forceinline__ float bfhi(unsigned w) { return __uint_as_float(w & 0xffff0000u); }
__device__ __forceinline__ float sigm(float v) { return __builtin_amdgcn_rcpf(1.f + __builtin_amdgcn_exp2f(-1.4426950408889634f * v)); }
__device__ __forceinline__ float silu(float v) { return v * sigm(v); }
__device__ __forceinline__ u32x4 pack8(const float (&o)[8]) { u32x4 w; w.x = cvt_pk_bf16(o[0], o[1]); w.y = cvt_pk_bf16(o[2], o[3]); w.z = cvt_pk_bf16(o[4], o[5]); w.w = cvt_pk_bf16(o[6], o[7]); return w; }

struct EpiUp {
    static constexpr bool PERM = true, AFTER_DRAIN = false, PREFETCH = true;
    __device__ __forceinline__ void prefetch(const Unit& u, PG8_LAS unsigned char* side, int tid, int wid) const {
        const float* src = wid < 4 ? rss + u.pm * BM + tid : bias + (size_t)(u.pm >> 3) * 5632 + u.pn * BM + (tid - 256);
        __builtin_amdgcn_global_load_lds((const unsigned*)src, (PG8_LAS unsigned*)(side + wid * 256), 4, 0, 0);
    }
    bf16_t* U; int ldu; const float* rss; const float* bias;
    __device__ __forceinline__ void operator()(const f32x4 (&acc)[2][2][4][2], const Unit& u, int wr, int wc, int fr, int fq, PG8_LAS const unsigned char* side) const {
        const int row0 = u.pm * BM + wr * 64 + fr, col0 = u.pn * 128 + wc * 32 + 8 * fq;
        f32x4 bv[2][2];
#pragma unroll
        for (int bj = 0; bj < 2; ++bj)
#pragma unroll
            for (int n = 0; n < 2; ++n) bv[bj][n] = *(PG8_LAS const f32x4*)(side + 1024 + 4 * (bj * HALF + wc * 32 + 8 * fq + 4 * n));
#pragma unroll
        for (int ai = 0; ai < 2; ++ai)
#pragma unroll
            for (int m = 0; m < 4; ++m) {
                const float rs = __builtin_amdgcn_rsqf(*(PG8_LAS const float*)(side + 4 * (ai * HALF + wr * 64 + m * 16 + fr)) * (1.f / 1024.f) + 1e-6f);
                float o[8];
#pragma unroll
                for (int n = 0; n < 2; ++n)
#pragma unroll
                    for (int e = 0; e < 4; ++e) o[4 * n + e] = silu(acc[ai][0][m][n][e] * rs + bv[0][n][e]) * (acc[ai][1][m][n][e] * rs + bv[1][n][e]);
                __builtin_nontemporal_store(pack8(o), (u32x4*)(U + (size_t)(row0 + ai * HALF + m * 16) * ldu + col0));
            }
    }
};
template <bool IN16, bool OUT16, bool NEXT, int SC2> struct EpiRes {
    static constexpr bool PERM = true, AFTER_DRAIN = false, PREFETCH = false;
    static constexpr int MB = IN16 ? 4 : 1;
    const void* xin; void* xout; const float* gate;
    bf16_t* Hn; const float* gn; const float* scn; float* rssn;
    __device__ __forceinline__ void operator()(const f32x4 (&acc)[2][2][4][2], const Unit& u, int wr, int wc, int fr, int fq) const {
        const int b = u.pm >> 3, col0 = u.pn * BM + wc * 32 + 8 * fq;
        f32x4 gv[2][2], an[2][2];
#pragma unroll
        for (int bj = 0; bj < 2; ++bj)
#pragma unroll
            for (int n = 0; n < 2; ++n) { gv[bj][n] = *(const f32x4*)(gate + (size_t)b * 9216 + col0 + bj * HALF + 4 * n) * (0.5f * (float)SC2);
                if (NEXT) an[bj][n] = *(const f32x4*)(gn + col0 + bj * HALF + 4 * n) * (*(const f32x4*)(scn + (size_t)b * 9216 + col0 + bj * HALF + 4 * n) + 1.0f); }
#pragma unroll
        for (int ai = 0; ai < 2; ++ai)
#pragma unroll
        for (int mb = 0; mb < 4; mb += MB) {
            u32x4 ph[MB][2]; f32x4 pf[MB][2][2];
#pragma unroll
            for (int mm = 0; mm < MB; ++mm)
#pragma unroll
                for (int bj = 0; bj < 2; ++bj) { const size_t off = (size_t)(u.pm * BM + ai * HALF + wr * 64 + (mb + mm) * 16 + fr) * 1024 + col0 + bj * HALF;
                    if (IN16) ph[mm][bj] = *(const u32x4*)((const bf16_t*)xin + off);
                    else { pf[mm][bj][0] = *(const f32x4*)((const float*)xin + off); pf[mm][bj][1] = *(const f32x4*)((const float*)xin + off + 4); } }
#pragma unroll
            for (int mm = 0; mm < MB; ++mm) { const int m = mb + mm; const int row = u.pm * BM + ai * HALF + wr * 64 + m * 16 + fr; float ss = 0.f;
#pragma unroll
                for (int bj = 0; bj < 2; ++bj) { const size_t off = (size_t)row * 1024 + col0 + bj * HALF;
                    f32x4 x0, x1;
                    if (IN16) { const u32x4 w = ph[mm][bj]; x0 = (f32x4){bflo(w.x), bfhi(w.x), bflo(w.y), bfhi(w.y)}; x1 = (f32x4){bflo(w.z), bfhi(w.z), bflo(w.w), bfhi(w.w)}; }
                    else { x0 = pf[mm][bj][0]; x1 = pf[mm][bj][1]; }
                    x0 = x0 + gv[bj][0] * acc[ai][bj][m][0]; x1 = x1 + gv[bj][1] * acc[ai][bj][m][1];
                    if (OUT16) { u32x4 w; w.x = cvt_pk_bf16(x0[0], x0[1]); w.y = cvt_pk_bf16(x0[2], x0[3]); w.z = cvt_pk_bf16(x1[0], x1[1]); w.w = cvt_pk_bf16(x1[2], x1[3]); *(u32x4*)((bf16_t*)xout + off) = w; }
                    else { *(f32x4*)((float*)xout + off) = x0; *(f32x4*)((float*)xout + off + 4) = x1; }
                    if (NEXT) { ss += ((x0[0] * x0[0] + x0[1] * x0[1]) + (x0[2] * x0[2] + x0[3] * x0[3])) + ((x1[0] * x1[0] + x1[1] * x1[1]) + (x1[2] * x1[2] + x1[3] * x1[3]));
                        const f32x4 h0 = x0 * an[bj][0], h1 = x1 * an[bj][1]; u32x4 w; w.x = cvt_pk_bf16(h0[0], h0[1]); w.y = cvt_pk_bf16(h0[2], h0[3]); w.z = cvt_pk_bf16(h1[0], h1[1]); w.w = cvt_pk_bf16(h1[2], h1[3]);
                        *(u32x4*)(Hn + off) = w; } }
                if (NEXT) { ss += __shfl_xor(ss, 16); ss += __shfl_xor(ss, 32); if (fq == 0) atomicAdd(rssn + row, ss); } }
        }
    }
};
struct EpiIn {
    static constexpr bool PERM = true, AFTER_DRAIN = false, PREFETCH = true;
    __device__ __forceinline__ void prefetch(const Unit& u, PG8_LAS unsigned char* side, int tid, int wid) const {
        const float* src = wid < 4 ? rss + u.pm * BM + tid : bias + (size_t)(u.pm >> 3) * 5120 + u.pn * BM + (tid - 256);
        __builtin_amdgcn_global_load_lds((const unsigned*)src, (PG8_LAS unsigned*)(side + wid * 256), 4, 0, 0);
    }
    unsigned char* ws; const float *gq, *gk, *bmerge; float qscale; const float* rss; const float* bias;
    static constexpr size_t Mi = 1u << 20, oTAB = 50 * Mi, oZ = 90 * Mi;
    static constexpr size_t oQA = oZ, oKA = oZ + 16 * Mi, oVA = oZ + 32 * Mi, oQR = oZ + 48 * Mi, oKR = oZ + 56 * Mi, oVR = oZ + 64 * Mi, oRG = oZ + 80 * Mi, oGA = oZ + 96 * Mi, oGR = oZ + 128 * Mi;
    __device__ __forceinline__ void operator()(const f32x4 (&acc)[2][2][4][2], const Unit& u, int wr, int wc, int fr, int fq, PG8_LAS const unsigned char* side) const {
        const int pn = u.pn, row0 = u.pm * BM + wr * 64 + fr, d0 = 8 * fq;
        { f32x4 (&accw)[2][2][4][2] = const_cast<f32x4 (&)[2][2][4][2]>(acc);
          f32x4 bz[2][2];
#pragma unroll
          for (int bj = 0; bj < 2; ++bj)
#pragma unroll
              for (int n = 0; n < 2; ++n) bz[bj][n] = *(PG8_LAS const f32x4*)(side + 1024 + 4 * (bj * HALF + wc * 32 + d0 + 4 * n));
#pragma unroll
          for (int ai = 0; ai < 2; ++ai)
#pragma unroll
              for (int m = 0; m < 4; ++m) { const float rs = __builtin_amdgcn_rsqf(*(PG8_LAS const float*)(side + 4 * (ai * HALF + wr * 64 + m * 16 + fr)) * (1.f / 1024.f) + 1e-6f);
#pragma unroll
                  for (int bj = 0; bj < 2; ++bj)
#pragma unroll
                      for (int n = 0; n < 2; ++n) accw[ai][bj][m][n] = accw[ai][bj][m][n] * rs + bz[bj][n]; }
          asm volatile("" ::: "memory"); }
#define ZV(ai, bj, m, n, e) (acc[ai][bj][m][n][e])
        if (pn < 4) {
            const bool isq = pn < 2; bf16_t* dst = (bf16_t*)(ws + (isq ? oQA : oKA)); const float* cosA = (const float*)(ws + oTAB); const float* sinA = (const float*)(ws + oTAB + 2 * Mi); const float* g = isq ? gq : gk; const float osc = isq ? qscale : 1.f;
            const int hh = 4 * (pn & 1) + wc;
            float g0[8], g1[8];
#pragma unroll
            for (int e = 0; e < 8; ++e) { g0[e] = g[d0 + e]; g1[e] = g[32 + d0 + e]; }
#pragma unroll
            for (int ai = 0; ai < 2; ++ai)
#pragma unroll
                for (int m = 0; m < 4; ++m) { const int row = row0 + ai * HALF + m * 16;
                    float x0[8], x1[8], ss = 0.f;
#pragma unroll
                    for (int n = 0; n < 2; ++n)
#pragma unroll
                        for (int e = 0; e < 4; ++e) { x0[4 * n + e] = ZV(ai, 0, m, n, e); x1[4 * n + e] = ZV(ai, 1, m, n, e); }
#pragma unroll
                    for (int e = 0; e < 8; ++e) ss += x0[e] * x0[e] + x1[e] * x1[e];
                    ss += __shfl_xor(ss, 16); ss += __shfl_xor(ss, 32);
                    const float rstd = __builtin_amdgcn_rsqf(ss * (1.f / 64.f) + 1e-6f);
                    const f32x4 c0 = *(const f32x4*)(cosA + (size_t)row * 32 + d0), c1 = *(const f32x4*)(cosA + (size_t)row * 32 + d0 + 4);
                    const f32x4 s0 = *(const f32x4*)(sinA + (size_t)row * 32 + d0), s1 = *(const f32x4*)(sinA + (size_t)row * 32 + d0 + 4);
                    float o0[8], o1[8];
#pragma unroll
                    for (int e = 0; e < 8; ++e) { const float c = e < 4 ? c0[e & 3] : c1[e & 3], s = e < 4 ? s0[e & 3] : s1[e & 3];
                        const float a = x0[e] * rstd * g0[e], bb = x1[e] * rstd * g1[e]; o0[e] = (a * c - bb * s) * osc; o1[e] = (bb * c + a * s) * osc; }
                    bf16_t* p = dst + (size_t)row * 512 + 64 * hh + d0;
                    *(u32x4*)p = pack8(o0); *(u32x4*)(p + 32) = pack8(o1); }
        } else if (pn == 6 || pn == 7) {
            bf16_t* dst = (bf16_t*)(ws + (pn == 6 ? oQR : oKR)); const float* cosR = (const float*)(ws + oTAB + 4 * Mi); const float* sinR = (const float*)(ws + oTAB + 6 * Mi); const float osc = pn == 6 ? 1.f : 0.125f;
#pragma unroll
            for (int ai = 0; ai < 2; ++ai)
#pragma unroll
                for (int m = 0; m < 4; ++m) { const int row = row0 + ai * HALF + m * 16;
                    const f32x4 c0 = *(const f32x4*)(cosR + (size_t)row * 32 + d0), c1 = *(const f32x4*)(cosR + (size_t)row * 32 + d0 + 4);
                    const f32x4 s0 = *(const f32x4*)(sinR + (size_t)row * 32 + d0), s1 = *(const f32x4*)(sinR + (size_t)row * 32 + d0 + 4);
                    float o0[8], o1[8];
#pragma unroll
                    for (int n = 0; n < 2; ++n)
#pragma unroll
                        for (int e = 0; e < 4; ++e) { const float c = n == 0 ? c0[e] : c1[e], s = n == 0 ? s0[e] : s1[e]; const float xe = ZV(ai, 0, m, n, e), xo = ZV(ai, 1, m, n, e);
                            o0[4 * n + e] = (xe * c - xo * s) * osc; o1[4 * n + e] = (xo * c + xe * s) * osc; }
                    bf16_t* p = dst + (size_t)row * 256 + 64 * wc + d0;
                    *(u32x4*)p = pack8(o0); *(u32x4*)(p + 32) = pack8(o1); }
        } else {
            bf16_t* dst; int ld, cb, op; const float* bias = nullptr;
            if (pn < 6) { dst = (bf16_t*)(ws + oVA); ld = 512; cb = 256 * (pn - 4); op = 0; }
            else if (pn < 10) { dst = (bf16_t*)(ws + oVR); ld = 512; cb = 256 * (pn - 8); op = 0; }
            else if (pn < 12) { dst = (bf16_t*)(ws + oRG); ld = 512; cb = 256 * (pn - 10); op = 1; }
            else if (pn < 16) { dst = (bf16_t*)(ws + oGA); ld = 1024; cb = 256 * (pn - 12); op = 2; bias = bmerge; }
            else { dst = (bf16_t*)(ws + oGR); ld = 1024; cb = 256 * (pn - 16); op = 2; bias = bmerge + 1024; }
#pragma unroll
            for (int bj = 0; bj < 2; ++bj) { const int col = cb + bj * HALF + wc * 32 + d0;
                f32x4 b0 = (f32x4){0.f, 0.f, 0.f, 0.f}, b1 = b0; if (op == 2) { b0 = *(const f32x4*)(bias + col); b1 = *(const f32x4*)(bias + col + 4); }
#pragma unroll
                for (int ai = 0; ai < 2; ++ai)
#pragma unroll
                    for (int m = 0; m < 4; ++m) { const int row = row0 + ai * HALF + m * 16; float o[8];
#pragma unroll
                        for (int e = 0; e < 4; ++e) { float v0 = ZV(ai, bj, m, 0, e) + b0[e], v1 = ZV(ai, bj, m, 1, e) + b1[e];
                            if (op == 1) { v0 = silu(v0); v1 = silu(v1); } else if (op == 2) { v0 = sigm(v0); v1 = sigm(v1); }
                            o[e] = v0; o[4 + e] = v1; }
                        *(u32x4*)(dst + (size_t)row * ld + col) = pack8(o); } }
        }
#undef ZV
    }
};
template <int MODE> struct EpiBr {
    static constexpr bool PERM = true, AFTER_DRAIN = false, PREFETCH = false;
    bf16_t* T; const bf16_t* G;
    __device__ __forceinline__ void operator()(const f32x4 (&acc)[2][2][4][2], const Unit& u, int wr, int wc, int fr, int fq) const {
        const int row0 = u.pm * BM + wr * 64 + fr, col0 = u.pn * BM + wc * 32 + 8 * fq;
#pragma unroll
        for (int ai = 0; ai < 2; ++ai) {
            u32x4 pg[4][2], pt[4][2];
#pragma unroll
            for (int m = 0; m < 4; ++m)
#pragma unroll
                for (int bj = 0; bj < 2; ++bj) { const size_t off = (size_t)(row0 + ai * HALF + m * 16) * 1024 + col0 + bj * HALF;
                    pg[m][bj] = *(const u32x4*)(G + off); if (MODE == 1) pt[m][bj] = *(const u32x4*)(T + off); else pt[m][bj] = (u32x4){0u, 0u, 0u, 0u}; }
#pragma unroll
            for (int m = 0; m < 4; ++m)
#pragma unroll
                for (int bj = 0; bj < 2; ++bj) { const size_t off = (size_t)(row0 + ai * HALF + m * 16) * 1024 + col0 + bj * HALF;
                    const u32x4 gw = pg[m][bj], tw = pt[m][bj];
                    const f32x4 a0 = acc[ai][bj][m][0], a1 = acc[ai][bj][m][1]; float o[8];
                    o[0] = bflo(gw.x) * a0[0]; o[1] = bfhi(gw.x) * a0[1]; o[2] = bflo(gw.y) * a0[2]; o[3] = bfhi(gw.y) * a0[3];
                    o[4] = bflo(gw.z) * a1[0]; o[5] = bfhi(gw.z) * a1[1]; o[6] = bflo(gw.w) * a1[2]; o[7] = bfhi(gw.w) * a1[3];
                    if (MODE == 1) { o[0] += bflo(tw.x); o[1] += bfhi(tw.x); o[2] += bflo(tw.y); o[3] += bfhi(tw.y); o[4] += bflo(tw.z); o[5] += bfhi(tw.z); o[6] += bflo(tw.w); o[7] += bfhi(tw.w); }
                    *(u32x4*)(T + off) = pack8(o); }
        }
    }
};
template <class Epi, class Sched, bool ALIGN_EPI = false, bool SP2 = false>
__device__ __forceinline__ void gemm_phase(PG8_LAS unsigned char* lds, const Gemm g, const Sched& S, const Epi& E) {
    const int tid = threadIdx.x, wid = __builtin_amdgcn_readfirstlane(tid >> 6), lane = tid & 63, wr = wid >> 2, wc = wid & 3, fr = lane & 15, fq = lane >> 4;
    const int K = g.K, nt = K / BK;
    unsigned voffA[2], voffB[2];
#pragma unroll
    for (int i = 0; i < 2; ++i) { int R, C; stage_rc(tid * 16 + i * 8192, R, C); const int Rb = Epi::PERM ? ((R & ~31) + perm32(R & 31)) : R;
        voffA[i] = (unsigned)(R * K + C) * 2u; voffB[i] = (unsigned)(Rb * K + C) * 2u; }
    const size_t kstep = (size_t)(BK * 2);
    const size_t hstep = (size_t)HALF * K * 2;
    const size_t tstep = 2 * hstep;
    const unsigned ldsw = (unsigned)wid * 1024u;
    const int aoff = lds_byte(wr * 64 + fr, fq * 8), boff = lds_byte(wc * 32 + fr, fq * 8);
#define PG8_SA(b, h) (((b) * 2 + (h)) * HTB)
#define PG8_SB(b, h) ((4 + (b) * 2 + (h)) * HTB)
#define PG8_STAGE(bufoff, gbase, voff) do { _Pragma("unroll") for (int _i = 0; _i < 2; ++_i) \
        __builtin_amdgcn_global_load_lds((const unsigned*)((const char*)(gbase) + (voff)[_i]), (PG8_LAS unsigned*)(lds + (bufoff) + ldsw + _i * 8192), 16, 0, 0); } while (0)
#define PG8_LDA(dst, b, h) do { _Pragma("unroll") for (int m = 0; m < 4; ++m) _Pragma("unroll") for (int k = 0; k < 2; ++k) dst[m][k] = *(const PG8_LAS bf16x8*)(lds + PG8_SA(b, h) + aoff + m * 2048 + k * 1024); } while (0)
#define PG8_LDB(dst, b, h) do { _Pragma("unroll") for (int n = 0; n < 2; ++n) _Pragma("unroll") for (int k = 0; k < 2; ++k) dst[n][k] = *(const PG8_LAS bf16x8*)(lds + PG8_SB(b, h) + boff + n * 2048 + k * 1024); } while (0)
#define PG8_MMA(ai, bj, At, Bt) do { __builtin_amdgcn_s_setprio(1); _Pragma("unroll") for (int m = 0; m < 4; ++m) _Pragma("unroll") for (int n = 0; n < 2; ++n) _Pragma("unroll") for (int k = 0; k < 2; ++k) \
        acc[ai][bj][m][n] = __builtin_amdgcn_mfma_f32_16x16x32_bf16(Bt[n][k], At[m][k], acc[ai][bj][m][n], 0, 0, 0); __builtin_amdgcn_s_setprio(0); } while (0)
#define PG8_WAIT_V(n) asm volatile("s_waitcnt vmcnt(" #n ")" ::: "memory")
#define PG8_WAIT_L(n) asm volatile("s_waitcnt lgkmcnt(" #n ")" ::: "memory")
#define PG8_BAR __builtin_amdgcn_s_barrier()
#define PG8_SCHED __builtin_amdgcn_sched_barrier(0)
    Unit cur, nxt; int ui = 0;
    if (!S.next(0, cur)) return;
    f32x4 acc[2][2][4][2];
#pragma unroll
    for (int a = 0; a < 2; ++a)
#pragma unroll
        for (int b = 0; b < 2; ++b)
#pragma unroll
            for (int m = 0; m < 4; ++m)
#pragma unroll
                for (int n = 0; n < 2; ++n) acc[a][b][m][n] = (f32x4){0.f, 0.f, 0.f, 0.f};
    bf16x8 At[4][2], B0[2][2], B1[2][2];
    const char* cA = (const char*)g.A + (size_t)cur.pm * tstep; const char* cB = (const char*)g.Bt + (size_t)cur.pn * tstep;
    S.a_ready(cur);
    if constexpr (SP2) {
        PG8_STAGE(PG8_SB(0, 0), cB, voffB); PG8_STAGE(PG8_SB(0, 1), cB + hstep, voffB); PG8_STAGE(PG8_SA(0, 0), cA, voffA); PG8_STAGE(PG8_SA(0, 1), cA + hstep, voffA);
        if (wr == 1) PG8_BAR;
        PG8_WAIT_V(2); PG8_BAR;
        PG8_STAGE(PG8_SB(1, 0), cB + kstep, voffB); PG8_STAGE(PG8_SA(1, 0), cA + kstep, voffA); PG8_STAGE(PG8_SB(1, 1), cB + hstep + kstep, voffB);
        PG8_WAIT_V(6); PG8_BAR;
    } else {
        PG8_STAGE(PG8_SB(0, 0), cB, voffB); PG8_STAGE(PG8_SA(0, 0), cA, voffA); PG8_STAGE(PG8_SB(0, 1), cB + hstep, voffB); PG8_STAGE(PG8_SA(0, 1), cA + hstep, voffA);
        if (wr == 1) PG8_BAR;
        PG8_WAIT_V(4); PG8_BAR;
        PG8_STAGE(PG8_SB(1, 0), cB + kstep, voffB); PG8_STAGE(PG8_SA(1, 0), cA + kstep, voffA); PG8_STAGE(PG8_SB(1, 1), cB + hstep + kstep, voffB);
        PG8_WAIT_V(6); PG8_BAR;
    }
    for (;;) {
        const bool has_next = S.next(ui + 1, nxt);
        PG8_LAS unsigned char* const side = lds + 132096 + (ui & 1) * 2048;
        if constexpr (Epi::PREFETCH) E.prefetch(cur, side, tid, wid);
        const char* nA = has_next ? (const char*)g.A + (size_t)nxt.pm * tstep : cA; const char* nB = has_next ? (const char*)g.Bt + (size_t)nxt.pn * tstep : cB;
        for (int t = 0; t < nt; t += 2) {
            const bool last = (t == nt - 2);
            const char* a1 = cA + (size_t)(t + 1) * kstep;
            const char* a2 = last ? nA : cA + (size_t)(t + 2) * kstep; const char* b2 = last ? nB : cB + (size_t)(t + 2) * kstep;
            const char* a3 = a2 + kstep; const char* b3 = b2 + kstep;
            if (last && has_next) S.a_ready(nxt);
            if constexpr (SP2) {
            PG8_LDB(B0, 0, 0); PG8_LDB(B1, 0, 1); PG8_SCHED; PG8_LDA(At, 0, 0); PG8_STAGE(PG8_SA(1, 1), a1 + hstep, voffA);
            PG8_WAIT_V(8); PG8_WAIT_L(0); PG8_BAR; PG8_MMA(0, 0, At, B0); PG8_MMA(0, 1, At, B1); PG8_BAR; PG8_SCHED;
            PG8_LDA(At, 0, 1); PG8_STAGE(PG8_SB(0, 0), b2, voffB); PG8_STAGE(PG8_SB(0, 1), b2 + hstep, voffB); PG8_STAGE(PG8_SA(0, 0), a2, voffA);
            PG8_WAIT_V(8); PG8_WAIT_L(0); PG8_BAR; PG8_MMA(1, 0, At, B0); PG8_MMA(1, 1, At, B1); PG8_BAR; PG8_SCHED;
            PG8_LDB(B0, 1, 0); PG8_LDB(B1, 1, 1); PG8_SCHED; PG8_LDA(At, 1, 0); PG8_STAGE(PG8_SA(0, 1), a2 + hstep, voffA);
            PG8_WAIT_V(8); PG8_WAIT_L(0); PG8_BAR; PG8_MMA(0, 0, At, B0); PG8_MMA(0, 1, At, B1); PG8_BAR; PG8_SCHED;
            PG8_LDA(At, 1, 1); PG8_STAGE(PG8_SB(1, 0), b3, voffB); PG8_STAGE(PG8_SB(1, 1), b3 + hstep, voffB); PG8_STAGE(PG8_SA(1, 0), a3, voffA);
            PG8_WAIT_V(8); PG8_WAIT_L(0); PG8_BAR; PG8_MMA(1, 0, At, B0); PG8_MMA(1, 1, At, B1); PG8_BAR; PG8_SCHED;
            } else {
            PG8_LDB(B0, 0, 0); PG8_SCHED; PG8_LDA(At, 0, 0); PG8_STAGE(PG8_SA(1, 1), a1 + hstep, voffA);
            PG8_WAIT_L(8); PG8_BAR; PG8_WAIT_L(0); PG8_MMA(0, 0, At, B0); PG8_BAR; PG8_SCHED;
            PG8_LDB(B1, 0, 1); PG8_STAGE(PG8_SB(0, 0), b2, voffB);
            PG8_BAR; PG8_WAIT_L(0); PG8_MMA(0, 1, At, B1); PG8_BAR;
            PG8_LDA(At, 0, 1); PG8_STAGE(PG8_SA(0, 0), a2, voffA);
            PG8_BAR; PG8_WAIT_L(0); PG8_MMA(1, 0, At, B0); PG8_BAR; PG8_SCHED;
            PG8_STAGE(PG8_SB(0, 1), b2 + hstep, voffB);
            PG8_WAIT_V(6); PG8_BAR; PG8_MMA(1, 1, At, B1); PG8_BAR;
            PG8_LDB(B0, 1, 0); PG8_SCHED; PG8_LDA(At, 1, 0); PG8_STAGE(PG8_SA(0, 1), a2 + hstep, voffA);
            PG8_WAIT_L(8); PG8_BAR; PG8_WAIT_L(0); PG8_MMA(0, 0, At, B0); PG8_BAR; PG8_SCHED;
            PG8_LDB(B1, 1, 1); PG8_STAGE(PG8_SB(1, 0), b3, voffB);
            PG8_BAR; PG8_WAIT_L(0); PG8_MMA(0, 1, At, B1); PG8_BAR;
            PG8_LDA(At, 1, 1); PG8_STAGE(PG8_SA(1, 0), a3, voffA);
            PG8_BAR; PG8_WAIT_L(0); PG8_MMA(1, 0, At, B0); PG8_BAR; PG8_SCHED;
            PG8_STAGE(PG8_SB(1, 1), b3 + hstep, voffB);
            PG8_WAIT_V(6); PG8_BAR; PG8_MMA(1, 1, At, B1); PG8_BAR;
            }
        }
        if constexpr (ALIGN_EPI) { if (wr == 0) PG8_BAR; }
        if constexpr (!Epi::AFTER_DRAIN) { if constexpr (Epi::PREFETCH) E(acc, cur, wr, wc, fr, fq, side); else E(acc, cur, wr, wc, fr, fq); S.done(cur); }
        if (!has_next) break;
#pragma unroll
        for (int a = 0; a < 2; ++a)
#pragma unroll
            for (int b = 0; b < 2; ++b)
#pragma unroll
                for (int m = 0; m < 4; ++m)
#pragma unroll
                    for (int n = 0; n < 2; ++n) acc[a][b][m][n] = (f32x4){0.f, 0.f, 0.f, 0.f};
        cur = nxt; cA = nA; cB = nB; ++ui;
        if constexpr (ALIGN_EPI) { if (wr == 1) PG8_BAR; }
    }
    PG8_WAIT_V(0);
    if constexpr (!ALIGN_EPI) { if (wr == 0) PG8_BAR; }
    PG8_BAR;
    if constexpr (Epi::AFTER_DRAIN) { E.fused(acc, cur, wr, wc, fr, fq, lds, wid, lane); S.done(cur); }
#undef PG8_SA
#undef PG8_SB
#undef PG8_STAGE
#undef PG8_LDA
#undef PG8_LDB
#undef PG8_MMA
#undef PG8_WAIT_V
#undef PG8_WAIT_L
#undef PG8_BAR
#undef PG8_SCHED
}
}
#define LAS __attribute__((address_space(3)))
typedef unsigned short bf16;
typedef unsigned u32x4 __attribute__((ext_vector_type(4)));
typedef float f32x4 __attribute__((ext_vector_type(4)));
typedef float f32x16 __attribute__((ext_vector_type(16)));
typedef short bf16x8 __attribute__((ext_vector_type(8)));
typedef short s16x4 __attribute__((ext_vector_type(4)));
typedef unsigned char uchar;
constexpr int NWAVES = 8;
constexpr int BATCH = 8, SEQ = 2048, D = 1024, FF = 2816, NIN = 5120, M = BATCH * SEQ, NMOD = 9 * D;
constexpr float LOG2E = 1.4426950408889634f;
constexpr float QSCALE = 0.125f * LOG2E;
constexpr size_t MiB = 1u << 20;
constexpr size_t WS_CTL = 0, CTL_ZERO_BYTES = 1 * MiB, WS_MOD = 65536;
constexpr size_t WS_W13A = 2 * MiB, WS_W2A = 13 * MiB, WS_WIN = 19 * MiB, WS_WA = 29 * MiB, WS_WR = 30 * MiB, WS_WO = 31 * MiB, WS_W13B = 33 * MiB, WS_W2B = 44 * MiB;
constexpr size_t WS_TAB = 50 * MiB;
constexpr size_t WS_H = 58 * MiB;
constexpr size_t WS_Z = 90 * MiB;
constexpr size_t WS_QA = WS_Z, WS_KA = WS_Z + 16 * MiB, WS_VA = WS_Z + 32 * MiB, WS_QR = WS_Z + 48 * MiB, WS_KR = WS_Z + 56 * MiB, WS_VR = WS_Z + 64 * MiB, WS_RG = WS_Z + 80 * MiB, WS_GA = WS_Z + 96 * MiB, WS_GR = WS_Z + 128 * MiB;
constexpr size_t WS_T = WS_KA;
constexpr size_t WS_END = 250 * MiB;
constexpr int RING_BYTES = 131072, LDS_BYTES = 147456;

#define LDS_WAIT() asm volatile("s_waitcnt lgkmcnt(0)" ::: "memory")
__device__ __forceinline__ unsigned cvtpk(float lo, float hi) { unsigned r; asm volatile("v_cvt_pk_bf16_f32 %0, %1, %2" : "=v"(r) : "v"(lo), "v"(hi)); return r; }
__device__ __forceinline__ float bf2f(unsigned short v) { return __uint_as_float((unsigned)v << 16); }
__device__ __forceinline__ unsigned short f2bf(float f) { return (unsigned short)(cvtpk(f, 0.f) & 0xffffu); }
__device__ __forceinline__ float wave_sum(float v) {
#pragma unroll
    for (int o = 1; o < 64; o <<= 1) v += __shfl_xor(v, o);
    return v;
}
__device__ __forceinline__ float ex2(float v) { return __builtin_amdgcn_exp2f(v); }

struct Args { const float* in[29]; float* out; unsigned char* ws; int ph_lo, ph_hi; };

__device__ __forceinline__ void tr_item(const float* W, int Nsrc, int scol0, int cstride, int k0, bf16* WT, int Kdst, int drow0, LAS float* scr, int lane) {
    if (cstride == 1) {
        f32x4 v[8]; const int c4 = lane & 7, kq = lane >> 3;
#pragma unroll
        for (int i = 0; i < 8; ++i) v[i] = __builtin_nontemporal_load((const f32x4*)(W + (size_t)(k0 + 8 * i + kq) * Nsrc + scol0 + 4 * c4));
#pragma unroll
        for (int i = 0; i < 8; ++i) { LAS float* d = scr + (8 * i + kq) * 33 + 4 * c4; d[0] = v[i].x; d[1] = v[i].y; d[2] = v[i].z; d[3] = v[i].w; }
    } else {
#pragma unroll 8
        for (int i = 0; i < 32; ++i) { const int kk = 2 * i + (lane >> 5); scr[kk * 33 + (lane & 31)] = W[(size_t)(k0 + kk) * Nsrc + scol0 + (lane & 31) * cstride]; }
    }
    LDS_WAIT(); asm volatile("" ::: "memory");
    const int c = lane & 7;
#pragma unroll
    for (int j = 0; j < 4; ++j) { const int n = (lane >> 3) + 8 * j; const LAS float* s = scr + (8 * c) * 33 + n;
        u32x4 o; o.x = cvtpk(s[0 * 33], s[1 * 33]); o.y = cvtpk(s[2 * 33], s[3 * 33]); o.z = cvtpk(s[4 * 33], s[5 * 33]); o.w = cvtpk(s[6 * 33], s[7 * 33]);
        *(u32x4*)(WT + (size_t)(drow0 + n) * Kdst + k0 + 8 * c) = o; }
    LDS_WAIT(); asm volatile("" ::: "memory");
}
__device__ __forceinline__ void tr_w13(const float* w1, const float* w3, bf16* WT, int it, LAS float* scr, int lane) {
    const int kb = it / 176, nb = it % 176, n0 = 32 * nb, pn = n0 >> 8, bj = (n0 >> 7) & 1, j0 = n0 & 127;
    tr_item(bj ? w3 : w1, FF, 128 * pn + j0, 1, 64 * kb, WT, D, n0, scr, lane);
}
__device__ __forceinline__ void tr_plain(const float* W, int K, int N, bf16* WT, int it, LAS float* scr, int lane) {
    const int nblk = N / 32, kb = it / nblk, nb = it % nblk;
    tr_item(W, N, 32 * nb, 1, 64 * kb, WT, K, 32 * nb, scr, lane);
}
__device__ __forceinline__ void tr_win(const float* W, bf16* WT, int it, LAS float* scr, int lane) {
    const int kb = it / 160, nb = it % 160, n0 = 32 * nb, pn = n0 >> 8, bj = (n0 >> 7) & 1, wc = (n0 >> 5) & 3;
    int scol0 = n0, cs = 1;
    if (pn < 4) scol0 = 256 * pn + 64 * wc + 32 * bj;
    else if (pn == 6 || pn == 7) { scol0 = 256 * pn + 64 * wc + bj; cs = 2; }
    tr_item(W, NIN, scol0, cs, 64 * kb, WT, D, n0, scr, lane);
}
__device__ __forceinline__ void norm_phase(const float* xin, const float* g, const float* sc, bf16* Hd, float* rss, int gw, int NGW, int lane) {
    for (int rb = gw; rb < M / 8; rb += NGW) {
        const int b = rb >> 8;
        f32x4 A[4];
#pragma unroll
        for (int j = 0; j < 4; ++j) { const int col = 4 * lane + 256 * j; const f32x4 gg = *(const f32x4*)(g + col), s1 = *(const f32x4*)(sc + (size_t)b * NMOD + col); A[j] = gg * (s1 + 1.0f); }
#pragma unroll 4
        for (int r = 0; r < 8; ++r) { const size_t row = (size_t)rb * 8 + r;
            f32x4 v[4]; float ss = 0.f;
#pragma unroll
            for (int j = 0; j < 4; ++j) { v[j] = __builtin_nontemporal_load((const f32x4*)(xin + row * D + 4 * lane + 256 * j)); ss += (v[j][0] * v[j][0] + v[j][1] * v[j][1]) + (v[j][2] * v[j][2] + v[j][3] * v[j][3]); }
            ss = wave_sum(ss); if (lane == 0) rss[row] = ss;
#pragma unroll
            for (int j = 0; j < 4; ++j) { const f32x4 o = v[j] * A[j];
                unsigned long long w = (unsigned long long)cvtpk(o[0], o[1]) | ((unsigned long long)cvtpk(o[2], o[3]) << 32);
                *(unsigned long long*)(Hd + row * D + 4 * lane + 256 * j) = w; } }
    }
}
__device__ __forceinline__ void bias_rows(const bf16* Wt, int N, const float* sh, float* biasv, int w0, int NW_, int lane) {
    f32x4 sv[8][4];
#pragma unroll
    for (int b = 0; b < 8; ++b)
#pragma unroll
        for (int q = 0; q < 4; ++q) sv[b][q] = *(const f32x4*)(sh + (size_t)b * NMOD + 16 * lane + 4 * q);
    for (int n0 = w0; n0 < N; n0 += 2 * NW_) {
        u32x4 wa[2], wb[2];
#pragma unroll
        for (int j = 0; j < 2; ++j) { const int n = n0 + j * NW_; const int nn = n < N ? n : w0; wa[j] = *(const u32x4*)(Wt + (size_t)nn * D + 16 * lane); wb[j] = *(const u32x4*)(Wt + (size_t)nn * D + 16 * lane + 8); }
#pragma unroll
        for (int j = 0; j < 2; ++j) { const int n = n0 + j * NW_;
            float wf[16];
            wf[0] = pg8::bflo(wa[j][0]); wf[1] = pg8::bfhi(wa[j][0]); wf[2] = pg8::bflo(wa[j][1]); wf[3] = pg8::bfhi(wa[j][1]); wf[4] = pg8::bflo(wa[j][2]); wf[5] = pg8::bfhi(wa[j][2]); wf[6] = pg8::bflo(wa[j][3]); wf[7] = pg8::bfhi(wa[j][3]);
            wf[8] = pg8::bflo(wb[j][0]); wf[9] = pg8::bfhi(wb[j][0]); wf[10] = pg8::bflo(wb[j][1]); wf[11] = pg8::bfhi(wb[j][1]); wf[12] = pg8::bflo(wb[j][2]); wf[13] = pg8::bfhi(wb[j][2]); wf[14] = pg8::bflo(wb[j][3]); wf[15] = pg8::bfhi(wb[j][3]);
            float res = 0.f;
#pragma unroll
            for (int b = 0; b < 8; ++b) { float d = 0.f;
#pragma unroll
                for (int q = 0; q < 4; ++q) d += (wf[4 * q] * sv[b][q][0] + wf[4 * q + 1] * sv[b][q][1]) + (wf[4 * q + 2] * sv[b][q][2] + wf[4 * q + 3] * sv[b][q][3]);
                d = wave_sum(d); if (lane == b) res = d; }
            if (lane < 8 && n < N) biasv[(size_t)lane * N + n] = res; }
    }
}

__device__ __forceinline__ s16x4 vtr(LAS const uchar* p) { return __builtin_amdgcn_ds_read_tr16_b64_v4i16((LAS s16x4*)p); }
__device__ __forceinline__ int crow(int r, int hi) { return (r & 3) + 8 * (r >> 2) + 4 * hi; }
__device__ __forceinline__ int voff(int row, int ch) { return 256 * row + 16 * (ch ^ (((row & 3) << 2) | ((row >> 2) & 3))); }
__device__ __forceinline__ int koff(int row, int ch) { return 128 * row + 16 * (ch ^ ((row >> 1) & 7)); }
__device__ __forceinline__ bf16x8 vfrag(LAS const uchar* vb, int ks, int c, int lane) {
    const int hi = lane >> 5, g1 = (lane >> 4) & 1, li = lane & 15, q = li >> 2, p = li & 3;
    const int ch = 4 * c + 2 * g1 + (p >> 1), r0 = 16 * ks + 4 * hi + q;
    const s16x4 lo = vtr(vb + voff(r0, ch) + 8 * (p & 1)), h4 = vtr(vb + voff(r0 + 8, ch) + 8 * (p & 1));
    return (bf16x8){lo[0], lo[1], lo[2], lo[3], h4[0], h4[1], h4[2], h4[3]};
}
__device__ __forceinline__ bf16x8 pack8f(const f32x16& p, int base) {
    u32x4 w; w.x = cvtpk(p[base + 0], p[base + 1]); w.y = cvtpk(p[base + 2], p[base + 3]); w.z = cvtpk(p[base + 4], p[base + 5]); w.w = cvtpk(p[base + 6], p[base + 7]);
    return __builtin_bit_cast(bf16x8, w);
}
#define MFMA32(a, b, c) __builtin_amdgcn_mfma_f32_32x32x16_bf16((a), (b), (c), 0, 0, 0)

__device__ __forceinline__ void attn_unit(LAS uchar* lds, int b, int h, int qb, const bf16* QA, const bf16* KA, const bf16* VA, bf16* OA, float negC, float lam, const float* subln) {
    const int tid = threadIdx.x, lane = tid & 63, wid = __builtin_amdgcn_readfirstlane(tid >> 6), qg = wid & 3, mp = wid >> 2, r32 = lane & 31, hi = lane >> 5;
    const size_t tokb = (size_t)b * SEQ; const int q0 = qb * 128 + qg * 32;
    bf16x8 qf[4];
    { const bf16* qp = QA + (tokb + q0 + r32) * 512 + h * 128 + mp * 64 + hi * 8;
#pragma unroll
      for (int s = 0; s < 4; ++s) qf[s] = *(const bf16x8*)(qp + 16 * s); }
    const int krow = tid >> 3, kch = (tid & 7) ^ ((krow >> 1) & 7), vrow0 = tid >> 4, vch = (tid & 15) ^ (((vrow0 & 3) << 2) | ((vrow0 >> 2) & 3));
    const bf16* kg0 = KA + (tokb + krow) * 512 + h * 128 + kch * 8;
    const bf16* vg0 = VA + (tokb + vrow0) * 512 + h * 128 + vch * 8;
#define AT_DMAK(t, koff_) do { const size_t o_ = (size_t)((t) < SEQ / 64 ? (t) : SEQ / 64 - 1) * 64 * 512; LAS uchar* bb_ = lds + (koff_) + wid * 1024; \
        __builtin_amdgcn_global_load_lds((const unsigned*)(kg0 + o_), (LAS unsigned*)(bb_), 16, 0, 0); \
        __builtin_amdgcn_global_load_lds((const unsigned*)(kg0 + o_ + 64), (LAS unsigned*)(bb_ + 8192), 16, 0, 0); } while (0)
#define AT_DMAV(t, voff_) do { const size_t o_ = (size_t)((t) < SEQ / 64 ? (t) : SEQ / 64 - 1) * 64 * 512; LAS uchar* bb_ = lds + 65536 + (voff_) + wid * 1024; \
        __builtin_amdgcn_global_load_lds((const unsigned*)(vg0 + o_), (LAS unsigned*)(bb_), 16, 0, 0); \
        __builtin_amdgcn_global_load_lds((const unsigned*)(vg0 + o_ + 32 * 512), (LAS unsigned*)(bb_ + 8192), 16, 0, 0); } while (0)
#define SGB(mask, n) __builtin_amdgcn_sched_group_barrier((mask), (n), 0)
    AT_DMAK(0, 0); AT_DMAK(1, 16384); AT_DMAK(2, 32768); AT_DMAV(0, 0); AT_DMAV(1, 16384);
    asm volatile("s_waitcnt vmcnt(0)" ::: "memory"); __syncthreads();
    int kb0, vb0;
    { const int y = (r32 >> 1) & 7; kb0 = 128 * r32 + 16 * (hi ^ y);
      const int g1 = (lane >> 4) & 1, li = lane & 15, q = li >> 2, p_ = li & 3;
      vb0 = 256 * (4 * hi + q) + 16 * ((q << 2) | ((2 * g1 + (p_ >> 1)) ^ (hi & 3))) + 8 * (p_ & 1); }
    f32x16 o[4];
#pragma unroll
    for (int c = 0; c < 4; ++c)
#pragma unroll
        for (int r = 0; r < 16; ++r) o[c][r] = 0.f;
    float lsum = 0.f;
    f32x16 pA0, pA1;
    { LAS const uchar* kb = lds + mp * 8192;
#pragma unroll
      for (int r = 0; r < 16; ++r) { pA0[r] = negC; pA1[r] = negC; }
#pragma unroll
      for (int s = 0; s < 4; ++s) { const bf16x8 k0 = *(LAS const bf16x8*)(kb + (kb0 ^ (s << 5))), k1 = *(LAS const bf16x8*)(kb + (kb0 ^ (s << 5)) + 4096);
          pA0 = MFMA32(k0, qf[s], pA0); pA1 = MFMA32(k1, qf[s], pA1); } }
    int k1o = 16384, k3o = 49152, v0o = 0, v2o = 32768;
    if (mp) __builtin_amdgcn_s_setprio(2);
    for (int kt = 0; kt < SEQ / 64; ++kt) {
        AT_DMAK(kt + 3, k3o); AT_DMAV(kt + 2, v2o);
        LAS const uchar* kbn = lds + k1o + mp * 8192; LAS const uchar* vb = lds + 65536 + v0o;
        __builtin_amdgcn_sched_barrier(0);
        f32x16 pB0, pB1;
#pragma unroll
        for (int r = 0; r < 16; ++r) { pB0[r] = negC; pB1[r] = negC; }
#pragma unroll
        for (int s = 0; s < 4; ++s) { const bf16x8 k0 = *(LAS const bf16x8*)(kbn + (kb0 ^ (s << 5))), k1 = *(LAS const bf16x8*)(kbn + (kb0 ^ (s << 5)) + 4096);
            pB0 = MFMA32(k0, qf[s], pB0); pB1 = MFMA32(k1, qf[s], pB1); }
        float sa = 0.f;
#pragma unroll
        for (int r = 0; r < 16; ++r) { pA0[r] = ex2(pA0[r]); sa += pA0[r]; }
        const bf16x8 pw0 = pack8f(pA0, 0), pw1 = pack8f(pA0, 8);
        SGB(0x100, 8);
#pragma unroll
        for (int i = 0; i < 8; ++i) { SGB(0x008, 1); SGB(0x002, 5); }
        __builtin_amdgcn_sched_barrier(0);
#pragma unroll
        for (int ks = 0; ks < 2; ++ks)
#pragma unroll
            for (int c = 0; c < 4; ++c) { const s16x4 lo = vtr(vb + (vb0 ^ (c << 6)) + 4096 * ks), h4 = vtr(vb + (vb0 ^ ((c << 6) | 32)) + 2048 + 4096 * ks);
                const bf16x8 vf = (bf16x8){lo[0], lo[1], lo[2], lo[3], h4[0], h4[1], h4[2], h4[3]};
                o[c] = MFMA32(ks ? pw1 : pw0, vf, o[c]); }
        float sb = 0.f;
#pragma unroll
        for (int r = 0; r < 16; ++r) { pA1[r] = ex2(pA1[r]); sb += pA1[r]; }
        lsum += sa + sb;
        const bf16x8 pw2 = pack8f(pA1, 0), pw3 = pack8f(pA1, 8);
        SGB(0x100, 4);
#pragma unroll
        for (int i = 0; i < 6; ++i) { SGB(0x008, 1); SGB(0x100, 2); SGB(0x002, 5); }
        SGB(0x008, 1); SGB(0x002, 5); SGB(0x008, 1); SGB(0x002, 5);
        __builtin_amdgcn_sched_barrier(0);
#pragma unroll
        for (int ks = 2; ks < 4; ++ks)
#pragma unroll
            for (int c = 0; c < 4; ++c) { const s16x4 lo = vtr(vb + (vb0 ^ (c << 6)) + 4096 * ks), h4 = vtr(vb + (vb0 ^ ((c << 6) | 32)) + 2048 + 4096 * ks);
                const bf16x8 vf = (bf16x8){lo[0], lo[1], lo[2], lo[3], h4[0], h4[1], h4[2], h4[3]};
                o[c] = MFMA32(ks == 2 ? pw2 : pw3, vf, o[c]); }
        SGB(0x100, 4);
#pragma unroll
        for (int i = 0; i < 6; ++i) { SGB(0x008, 1); SGB(0x100, 2); }
        SGB(0x008, 1); SGB(0x008, 1);
        __builtin_amdgcn_sched_barrier(0);
        pA0 = pB0; pA1 = pB1;
        k1o = (k1o + 16384) & 65535; k3o = (k3o + 16384) & 65535; v0o = (v0o == 32768) ? 0 : v0o + 16384; v2o = (v2o == 32768) ? 0 : v2o + 16384;
        asm volatile("s_waitcnt vmcnt(4) lgkmcnt(0)" ::: "memory"); __builtin_amdgcn_s_barrier(); asm volatile("" ::: "memory");
    }
    __builtin_amdgcn_s_setprio(0);
#undef AT_DMAK
#undef AT_DMAV
    asm volatile("s_waitcnt vmcnt(0)" ::: "memory"); __syncthreads();
#undef SGB
    lsum += __shfl_xor(lsum, 32);
    LAS float* lb = (LAS float*)(lds + 114688) + wid * 32;
    if (hi == 0) lb[r32] = (mp ? lam : 1.f) / lsum;
    LDS_WAIT(); asm volatile("" ::: "memory");
    float rl[16];
#pragma unroll
    for (int r = 0; r < 16; ++r) rl[r] = lb[crow(r, hi)];
    LAS float* X = (LAS float*)lds + qg * 4096;
    if (mp == 1) {
#pragma unroll
        for (int c = 0; c < 4; ++c)
#pragma unroll
            for (int r = 0; r < 16; ++r) X[crow(r, hi) * 128 + 32 * c + r32] = o[c][r] * rl[r];
    }
    __syncthreads();
    if (mp == 0) {
        float ssq[16];
#pragma unroll
        for (int r = 0; r < 16; ++r) ssq[r] = 0.f;
#pragma unroll
        for (int c = 0; c < 4; ++c)
#pragma unroll
            for (int r = 0; r < 16; ++r) { const float v = o[c][r] * rl[r] - X[crow(r, hi) * 128 + 32 * c + r32]; o[c][r] = v; ssq[r] += v * v; }
#pragma unroll
        for (int r = 0; r < 16; ++r) {
#pragma unroll
            for (int x = 1; x < 32; x <<= 1) ssq[r] += __shfl_xor(ssq[r], x);
            ssq[r] = __builtin_amdgcn_rsqf(ssq[r] * (1.f / 128.f) + 1e-6f) * 0.8f; }
#pragma unroll
        for (int c = 0; c < 4; ++c) { const float sg = subln[32 * c + r32];
#pragma unroll
            for (int r = 0; r < 16; ++r) OA[(tokb + q0 + crow(r, hi)) * 512 + h * 128 + 32 * c + r32] = f2bf(o[c][r] * ssq[r] * sg); }
    }
    __syncthreads();
}

__device__ __forceinline__ void ret_state_task(LAS uchar* wl, int task, const bf16* KR, const bf16* VR, bf16* RT, const float* dec_f, const float* dec_b, int lane) {
    const int dt = task & 3, et = (task >> 2) & 7, dir = (task >> 5) & 1, h = (task >> 6) & 3, b = task >> 8;
    const float x = dir ? dec_b[h] : dec_f[h];
    const float lg2 = -log1pf(expf(-x)) * LOG2E, decay = ex2(128.f * lg2);
    f32x4 st = (f32x4){0.f, 0.f, 0.f, 0.f};
    const int g = lane >> 4, li = lane & 15, q = li >> 2, p = li & 3, hc = lane & 1;
    u32x4 vvA[4], kkA[4], vvB[4], kkB[4];
#define RS_LOAD(VV, KK, nn) do { const size_t t0_ = (size_t)b * SEQ + (nn) * 128; _Pragma("unroll") for (int i = 0; i < 4; ++i) { const int row = 32 * i + (lane >> 1); \
        VV[i] = *(const u32x4*)(VR + (t0_ + row) * 512 + 128 * h + 16 * et + 8 * hc); KK[i] = *(const u32x4*)(KR + (t0_ + row) * 256 + 64 * h + 16 * dt + 8 * hc); } } while (0)
#define RS_STEP(step, VV, KK) do { \
        const int n = dir ? 15 - (step) : (step); \
        bf16* rt = RT + ((((size_t)(b * 4 + h) * 2 + dir) * 16 + n) * 128 + 16 * et) * 64 + 16 * dt; \
        _Pragma("unroll") for (int r = 0; r < 4; ++r) rt[(4 * g + r) * 64 + li] = f2bf(st[r]); \
        if ((step) < 15) { \
            _Pragma("unroll") for (int i = 0; i < 4; ++i) { const int row = 32 * i + (lane >> 1); \
                const float z = dir ? ex2((float)row * lg2) : ex2((float)(127 - row) * lg2); \
                u32x4 ks; ks.x = cvtpk(pg8::bflo(KK[i].x) * z, pg8::bfhi(KK[i].x) * z); ks.y = cvtpk(pg8::bflo(KK[i].y) * z, pg8::bfhi(KK[i].y) * z); ks.z = cvtpk(pg8::bflo(KK[i].z) * z, pg8::bfhi(KK[i].z) * z); ks.w = cvtpk(pg8::bflo(KK[i].w) * z, pg8::bfhi(KK[i].w) * z); \
                *(LAS u32x4*)(wl + row * 32 + 16 * hc) = VV[i]; *(LAS u32x4*)(wl + 4096 + row * 32 + 16 * hc) = ks; } \
            if ((step) + 2 < 15) RS_LOAD(VV, KK, dir ? 13 - (step) : (step) + 2); \
            f32x4 acc = (f32x4){0.f, 0.f, 0.f, 0.f}; \
            _Pragma("unroll") for (int s_ = 0; s_ < 4; ++s_) { const int ra = 32 * s_ + 8 * g + q; \
                const s16x4 a0 = vtr(wl + ra * 32 + 8 * p), a1 = vtr(wl + (ra + 4) * 32 + 8 * p), b0 = vtr(wl + 4096 + ra * 32 + 8 * p), b1 = vtr(wl + 4096 + (ra + 4) * 32 + 8 * p); \
                const bf16x8 A = (bf16x8){a0[0], a0[1], a0[2], a0[3], a1[0], a1[1], a1[2], a1[3]}, B = (bf16x8){b0[0], b0[1], b0[2], b0[3], b1[0], b1[1], b1[2], b1[3]}; \
                acc = __builtin_amdgcn_mfma_f32_16x16x32_bf16(A, B, acc, 0, 0, 0); } \
            st = st * decay + acc; \
            LDS_WAIT(); asm volatile("" ::: "memory"); } } while (0)
    RS_LOAD(vvA, kkA, dir ? 15 : 0); RS_LOAD(vvB, kkB, dir ? 14 : 1);
#pragma unroll 1
    for (int step = 0; step < 16; step += 2) { RS_STEP(step, vvA, kkA); RS_STEP(step + 1, vvB, kkB); }
#undef RS_LOAD
#undef RS_STEP
}

__device__ __forceinline__ void ret_unit(LAS uchar* lds, int b, int h, int n, const bf16* QR, const bf16* KR, bf16* VRY, const bf16* RT, const bf16* RG, const float* ret_norm, float lgf2, float lgb2, bool nostore) {
    int tid = threadIdx.x; asm volatile("" : "+v"(tid));
    const int lane = tid & 63, wid = __builtin_amdgcn_readfirstlane(tid >> 6), ib = wid & 3, eh = wid >> 2, r32 = lane & 31, hi = lane >> 5;
    const size_t tok0 = (size_t)b * SEQ + n * 128;
    bf16x8 rtf[2][4], rtb[2][4];
#pragma unroll
    for (int cc = 0; cc < 2; ++cc) {
        const bf16* rF = RT + ((((size_t)(b * 4 + h) * 2 + 0) * 16 + n) * 128 + 64 * eh + 32 * cc + r32) * 64 + 8 * hi;
        const bf16* rB = rF + (size_t)16 * 128 * 64;
#pragma unroll
        for (int s = 0; s < 4; ++s) { rtf[cc][s] = *(const bf16x8*)(rF + 16 * s); rtb[cc][s] = *(const bf16x8*)(rB + 16 * s); } }
    { u32x4 tk[2], tv[4];
#pragma unroll
      for (int i = 0; i < 2; ++i) { const int pc = tid + 512 * i, row = pc >> 3, ch = pc & 7; tk[i] = *(const u32x4*)(KR + (tok0 + row) * 256 + 64 * h + 8 * ch); }
#pragma unroll
      for (int i = 0; i < 4; ++i) { const int pc = tid + 512 * i, row = pc >> 4, ch = pc & 15; tv[i] = *(const u32x4*)(VRY + (tok0 + row) * 512 + 128 * h + 8 * ch); }
#pragma unroll
      for (int i = 0; i < 2; ++i) { const int pc = tid + 512 * i, row = pc >> 3, ch = pc & 7; *(LAS u32x4*)(lds + koff(row, ch)) = tk[i]; }
#pragma unroll
      for (int i = 0; i < 4; ++i) { const int pc = tid + 512 * i, row = pc >> 4, ch = pc & 15; *(LAS u32x4*)(lds + 16384 + voff(row, ch)) = tv[i]; } }
    bf16x8 qf[4];
    { const bf16* qp = QR + (tok0 + 32 * ib + r32) * 256 + 64 * h + 8 * hi;
#pragma unroll
      for (int s = 0; s < 4; ++s) qf[s] = *(const bf16x8*)(qp + 16 * s); }
    __syncthreads();
    f32x16 y[2];
#pragma unroll
    for (int cc = 0; cc < 2; ++cc) {
        f32x16 af, ab;
#pragma unroll
        for (int r = 0; r < 16; ++r) { af[r] = 0.f; ab[r] = 0.f; }
#pragma unroll
        for (int s = 0; s < 4; ++s) { af = MFMA32(qf[s], rtf[cc][s], af); ab = MFMA32(qf[s], rtb[cc][s], ab); }
#pragma unroll
        for (int r = 0; r < 16; ++r) { const int i = 32 * ib + crow(r, hi); y[cc][r] = ex2((float)(i + 1) * lgf2) * af[r] + ex2((float)(128 - i) * lgb2) * ab[r]; }
    }
    LAS const uchar* vb = lds + 16384;
#pragma unroll
    for (int jb = 0; jb < 4; ++jb) {
        f32x16 st;
#pragma unroll
        for (int r = 0; r < 16; ++r) st[r] = 0.f;
#pragma unroll
        for (int s = 0; s < 4; ++s) { const bf16x8 kf = *(LAS const bf16x8*)(lds + koff(32 * jb + r32, 2 * s + hi)); st = MFMA32(kf, qf[s], st); }
#pragma unroll
        for (int r = 0; r < 16; ++r) { const int df = (32 * ib + r32) - (32 * jb + crow(r, hi));
            const float fac = df > 0 ? ex2((float)df * lgf2) : (df < 0 ? ex2((float)(-df) * lgb2) : 2.0f); st[r] *= fac; }
        const bf16x8 pw0 = pack8f(st, 0), pw1 = pack8f(st, 8);
#pragma unroll
        for (int cc = 0; cc < 2; ++cc) { y[cc] = MFMA32(pw0, vfrag(vb, 2 * jb, 2 * eh + cc, lane), y[cc]); y[cc] = MFMA32(pw1, vfrag(vb, 2 * jb + 1, 2 * eh + cc, lane), y[cc]); }
    }
    float ssq[16];
#pragma unroll
    for (int r = 0; r < 16; ++r) { float v = y[0][r] * y[0][r] + y[1][r] * y[1][r];
#pragma unroll
        for (int x = 1; x < 32; x <<= 1) v += __shfl_xor(v, x);
        ssq[r] = v; }
    unsigned short rgv[2][16];
#pragma unroll
    for (int cc = 0; cc < 2; ++cc)
#pragma unroll
        for (int r = 0; r < 16; ++r) rgv[cc][r] = RG[(tok0 + 32 * ib + crow(r, hi)) * 512 + 128 * h + 64 * eh + 32 * cc + r32];
    LAS float* sbuf = (LAS float*)(lds + 49152);
    if (r32 == 0) {
#pragma unroll
        for (int r = 0; r < 16; ++r) sbuf[wid * 32 + crow(r, hi)] = ssq[r]; }
    __syncthreads();
#pragma unroll
    for (int r = 0; r < 16; ++r) ssq[r] = __builtin_amdgcn_rsqf((ssq[r] + sbuf[(wid ^ 4) * 32 + crow(r, hi)]) * (1.f / 128.f) + 1e-6f);
#pragma unroll
    for (int cc = 0; cc < 2; ++cc) { const int e = 64 * eh + 32 * cc + r32; const float gn = ret_norm[e];
#pragma unroll
        for (int r = 0; r < 16; ++r) { const size_t off = (tok0 + 32 * ib + crow(r, hi)) * 512 + 128 * h + e; const unsigned short ov = f2bf(y[cc][r] * ssq[r] * gn * bf2f(rgv[cc][r])); if (!nostore) VRY[off] = ov; } }
    __syncthreads();
}
#define RLX_AGENT __ATOMIC_RELAXED, __HIP_MEMORY_SCOPE_AGENT
#define XB_TMO      128
#define XB_XCNT(j)  (256  + 64 * (j))
#define XB_XSUB(j)  (1280 + 64 * (j))
#define XB_XGEN(j)  (2304 + 64 * (j))
#define XB_TOP      3328
#define XB_TOPGEN   3392
#define XCD_BAR_WORDS 3456
#define XB_SPIN_CAP (1u << 18)

__device__ __forceinline__ unsigned xb_ld(unsigned* p)              { return __hip_atomic_load(p, __ATOMIC_RELAXED, __HIP_MEMORY_SCOPE_AGENT); }
__device__ __forceinline__ unsigned xb_add(unsigned* p, unsigned v) { return __hip_atomic_fetch_add(p, v, __ATOMIC_RELAXED, __HIP_MEMORY_SCOPE_AGENT); }
__device__ __forceinline__ unsigned xb_xcc_id() { return (unsigned)__builtin_amdgcn_s_getreg((3 << 11) | 20) & 0xFu; }
#define XB_SPIN(cond, bar) do { unsigned _sp = 0; while (cond) { __builtin_amdgcn_s_sleep(1); \
    if ((++_sp & 255u) == 0u) { if (xb_ld(&(bar)[XB_TMO])) break; if (_sp > XB_SPIN_CAP) { atomicAdd(&(bar)[XB_TMO], 1u); break; } } } } while (0)

struct XcdBarrier {
    unsigned* bar; unsigned x;
    volatile LAS unsigned* st;
};

__device__ __forceinline__ XcdBarrier xcd_barrier_post(unsigned* bar, volatile LAS unsigned* st) {
    XcdBarrier b; b.bar = bar; b.x = xb_xcc_id(); b.st = st;
    if (threadIdx.x == 0) (void)xb_add(&bar[XB_XCNT(b.x)], 1u);
    return b;
}
__device__ __forceinline__ void xcd_barrier_complete(unsigned* bar, unsigned x, unsigned& nloc, unsigned& nx) {
    const unsigned G = gridDim.x * gridDim.y * gridDim.z;
    unsigned sum, cnt, mine, sp = 0u;
    for (;;) {
        sum = 0u; cnt = 0u; mine = 0u;
#pragma unroll
        for (unsigned j = 0; j < 16; ++j) { const unsigned c = xb_ld(&bar[XB_XCNT(j)]); sum += c; cnt += (c > 0u) ? 1u : 0u; mine = (j == x) ? c : mine; }
        if (sum == G) break;
        __builtin_amdgcn_s_sleep(1);
        if ((++sp & 255u) == 0u) { if (xb_ld(&bar[XB_TMO])) break; if (sp > XB_SPIN_CAP) { atomicAdd(&bar[XB_TMO], 1u); break; } }
    }
    nloc = mine > 0u ? mine : 1u; nx = cnt > 0u ? cnt : 1u;
}

__device__ __forceinline__ void xcd_barrier(const XcdBarrier& b) {
    asm volatile("s_waitcnt vmcnt(0)" ::: "memory");
    __syncthreads();
    if (threadIdx.x == 0) {
        unsigned* bar = b.bar;
        __builtin_amdgcn_s_waitcnt(0);
        unsigned nloc = b.st[0], nx = b.st[1];
        if (nloc == 0u) { xcd_barrier_complete(bar, b.x, nloc, nx); b.st[0] = nloc; b.st[1] = nx; }
        const unsigned old = xb_add(&bar[XB_XSUB(b.x)], 1u);
        const unsigned gen = old / nloc;
        if (old + 1u == (gen + 1u) * nloc) {
            __builtin_amdgcn_fence(__ATOMIC_RELEASE, "agent");
            asm volatile("s_waitcnt vmcnt(0)" ::: "memory");
            const unsigned og = xb_add(&bar[XB_TOP], 1u);
            const unsigned tg = og / nx;
            if (og + 1u == (tg + 1u) * nx) xb_add(&bar[XB_TOPGEN], 1u);
            else XB_SPIN(xb_ld(&bar[XB_TOPGEN]) == tg, bar);
            __builtin_amdgcn_fence(__ATOMIC_ACQUIRE, "agent");
            xb_add(&bar[XB_XGEN(b.x)], 1u);
            asm volatile("s_waitcnt vmcnt(0)" ::: "memory");
        } else {
            XB_SPIN(xb_ld(&bar[XB_XGEN(b.x)]) == gen, bar);
            __builtin_amdgcn_fence(__ATOMIC_ACQUIRE, "agent");
            asm volatile("s_waitcnt vmcnt(0)" ::: "memory");
        }
    }
    __syncthreads();
}

#ifndef MK_N_LAUNCHES
#define MK_N_LAUNCHES 1
#endif
constexpr int N_PHASES = 12;
__global__ void __launch_bounds__(NWAVES * 64, 2) mk_fwd(Args args) {
    extern __shared__ __attribute__((aligned(16))) unsigned char lds_raw[];
    LAS uchar* lds = (LAS uchar*)lds_raw;
    cg::grid_group grid = cg::this_grid();
    const int tid = threadIdx.x, lane = tid & 63, wave = __builtin_amdgcn_readfirstlane(tid >> 6);
    const int G = gridDim.x, bx = blockIdx.x, vcu = (G % 8 == 0) ? (bx % 8) * (G / 8) + bx / 8 : bx;
    const int gw = vcu * NWAVES + wave, NGW = G * NWAVES;
    uchar* ws = args.ws;
    volatile LAS unsigned* MISC = (volatile LAS unsigned*)(lds + RING_BYTES + 320);
    if (tid < 64) ((LAS unsigned*)(lds + RING_BYTES))[tid * 2] = 0u, ((LAS unsigned*)(lds + RING_BYTES))[tid * 2 + 1] = 0u;
    __syncthreads();
    if (args.ph_lo == 0x7fffffff) grid.sync();
    XcdBarrier bar = xcd_barrier_post((unsigned*)(ws + WS_CTL + 512 * 1024), MISC + 8);
#define x (args.in[0])
#define cvec (args.in[1])
#define positions ((const int*)args.in[2])
#define w_ada (args.in[3])
#define b_ada (args.in[4])
#define out (args.out)
#define mod ((float*)(ws + WS_MOD))
#define W13A ((bf16*)(ws + WS_W13A))
#define W2A ((bf16*)(ws + WS_W2A))
#define WIN ((bf16*)(ws + WS_WIN))
#define WA ((bf16*)(ws + WS_WA))
#define WR ((bf16*)(ws + WS_WR))
#define WO ((bf16*)(ws + WS_WO))
#define W13B ((bf16*)(ws + WS_W13B))
#define W2B ((bf16*)(ws + WS_W2B))
#define cosA ((float*)(ws + WS_TAB))
#define sinA ((float*)(ws + WS_TAB + 2 * MiB))
#define cosR ((float*)(ws + WS_TAB + 4 * MiB))
#define sinR ((float*)(ws + WS_TAB + 6 * MiB))
#define H ((bf16*)(ws + WS_H))
#define RT ((bf16*)(ws + WS_H))
#define U ((bf16*)(ws + WS_Z))
#define QA ((bf16*)(ws + WS_QA))
#define KA ((bf16*)(ws + WS_KA))
#define VA ((bf16*)(ws + WS_VA))
#define QR ((bf16*)(ws + WS_QR))
#define KR ((bf16*)(ws + WS_KR))
#define VR ((bf16*)(ws + WS_VR))
#define RG ((bf16*)(ws + WS_RG))
#define GA ((bf16*)(ws + WS_GA))
#define GR ((bf16*)(ws + WS_GR))
#define T ((bf16*)(ws + WS_T))
#define OA ((bf16*)(ws + WS_H + 16 * MiB))
#define RSS ((float*)(ws + WS_CTL + 768 * 1024))
#define X1B ((bf16*)out)
#define X2B ((bf16*)(ws + WS_GA))
#define BIAS1 ((float*)(ws + 250 * MiB))
#define BIAS2 ((float*)(ws + 250 * MiB + 256 * 1024))
#define BIAS3 ((float*)(ws + 250 * MiB + 512 * 1024))
    const int lo = args.ph_lo, hi_ph = args.ph_hi;
#ifndef PHMASK
#define PHMASK 0xffff
#endif
#define IN(k) (((PHMASK >> (k)) & 1) && lo <= (k) && (k) < hi_ph)
#ifndef DUPMASK
#define DUPMASK 0
#endif
#define REPS(k) _Pragma("unroll") for (int rep_ = 0; rep_ < (((DUPMASK >> (k)) & 1) ? 2 : 1); ++rep_)
#ifndef TMASK
#define TMASK 0
#endif
    unsigned long long tacc_ = 0ull, tb_ = 0ull;
#define TB(k) do { if ((TMASK >> (k)) & 1) tb_ = __builtin_amdgcn_s_memrealtime(); } while (0)
#define TE(k) do { if ((TMASK >> (k)) & 1) tacc_ += __builtin_amdgcn_s_memrealtime() - tb_; } while (0)
#define SEAM(k) do { if (IN(k) && hi_ph > (k) + 1) { TB(13); xcd_barrier(bar); TE(13); } } while (0)

    TB(0);
    if (IN(0)) REPS(0) {
        LAS float* scr = (LAS float*)(lds + wave * 16384);
        constexpr int I13 = 16 * 176, I2 = 44 * 32, IIN = 16 * 160, IBR = 8 * 32, IO = 16 * 32;
        for (int task = bx * NWAVES + wave; task < 36 * 32; task += NGW) {
            const int cgp = task % 36, ks = task / 36, n = 256 * cgp + 4 * lane;
            f32x4 a[8];
#pragma unroll
            for (int b = 0; b < 8; ++b) a[b] = (f32x4){0.f, 0.f, 0.f, 0.f};
#pragma unroll 1
            for (int k4 = 0; k4 < 1; ++k4) {
                float sv[8];
#pragma unroll
                for (int b = 0; b < 8; ++b) sv[b] = pg8::silu(cvec[b * D + 32 * ks + 32 * k4 + (lane & 31)]);
#pragma unroll 16
                for (int kk = 0; kk < 32; ++kk) { const f32x4 w = __builtin_nontemporal_load((const f32x4*)(w_ada + (size_t)(32 * ks + 32 * k4 + kk) * NMOD + n));
#pragma unroll
                    for (int b = 0; b < 8; ++b) a[b] += w * __uint_as_float(__builtin_amdgcn_readlane(__float_as_uint(sv[b]), kk)); }
            }
            f32x4 bias = (f32x4){0.f, 0.f, 0.f, 0.f}; if (ks == 0) bias = *(const f32x4*)(b_ada + n);
#pragma unroll
            for (int b = 0; b < 8; ++b) { float* mp_ = (rep_ == 0 ? mod : (float*)(ws + WS_CTL + 640 * 1024)) + (size_t)b * NMOD + n; atomicAdd(mp_ + 0, a[b][0] + bias[0]); atomicAdd(mp_ + 1, a[b][1] + bias[1]); atomicAdd(mp_ + 2, a[b][2] + bias[2]); atomicAdd(mp_ + 3, a[b][3] + bias[3]); }
        }
        for (int it = gw; it < I13 + I2; it += NGW) {
            int r = it;
            if (r < I13) { tr_w13(args.in[6], args.in[7], W13A, r, scr, lane); continue; } r -= I13;
            tr_plain(args.in[8], FF, D, W2A, r, scr, lane);
        }
        for (int idx = (vcu * NWAVES * 64 + tid); idx < M * 32; idx += G * NWAVES * 64) {
            const int tok = idx >> 5, i = idx & 31; const double pos = (double)positions[tok];
            const double TWO_PI_HI = 6.283185307179586, TWO_PI_LO = 2.4492935982947064e-16, INV2PI = 0.15915494309189535;
            { const double inv = exp2(-13.287712379549449 * (double)i / 32.0); const double a = pos * inv, k = rint(a * INV2PI); double r = fma(-k, TWO_PI_HI, a); r = fma(-k, TWO_PI_LO, r); const float rf = (float)r; cosA[idx] = cosf(rf); sinA[idx] = sinf(rf); }
            { const double inv = exp2(-13.287712379549449 * (double)i / 31.0); const double a = pos * inv, k = rint(a * INV2PI); double r = fma(-k, TWO_PI_HI, a); r = fma(-k, TWO_PI_LO, r); const float rf = (float)r; cosR[idx] = cosf(rf); sinR[idx] = sinf(rf); }
        }
    }
    TE(0);
    SEAM(0);
#ifdef XSYNC
    for (int i_ = 0; i_ < XSYNC; ++i_) xcd_barrier(bar);
#endif
    TB(1);
    if (IN(1)) REPS(1) { norm_phase(x, args.in[5], mod + 1 * D, H, RSS, gw, NGW, lane);
        bias_rows(W13A, 2 * FF, mod + 0 * D, BIAS1, gw, NGW, lane); }
    TE(1);
    SEAM(1);
    TB(2);
    if (IN(2)) REPS(2) { pg8::Gemm g{H, W13A, M, 2 * FF, D}; pg8::StaticOrder S; S.init(M, 2 * FF, G, bx); pg8::EpiUp E{U, FF, RSS, BIAS1};
        pg8::gemm_phase<pg8::EpiUp, pg8::StaticOrder, true, true>(lds, g, S, E);
        if (rep_ == 0) {
            constexpr int I13 = 16 * 176, I2 = 44 * 32, IIN = 16 * 160, IBR = 8 * 32, IO = 16 * 32, NLATE = IIN + 2 * IBR + IO + I13 + I2;
            const int rem = ((M / 256) * (2 * FF / 256)) % G; const bool all = rem == 0;
            if (all || bx >= rem) {
                LAS float* scr = (LAS float*)(lds + wave * 16384);
                const int w0_ = (all ? bx : bx - rem) * NWAVES + wave, nw_ = (all ? G : G - rem) * NWAVES;
                for (int it = w0_; it < NLATE; it += nw_) {
                    int r = it;
                    if (r < IIN) { tr_win(args.in[10], WIN, r, scr, lane); continue; } r -= IIN;
                    if (r < IBR) { tr_plain(args.in[22], 512, D, WA, r, scr, lane); continue; } r -= IBR;
                    if (r < IBR) { tr_plain(args.in[23], 512, D, WR, r, scr, lane); continue; } r -= IBR;
                    if (r < IO) { tr_plain(args.in[24], D, D, WO, r, scr, lane); continue; } r -= IO;
                    if (r < I13) { tr_w13(args.in[26], args.in[27], W13B, r, scr, lane); continue; } r -= I13;
                    tr_plain(args.in[28], FF, D, W2B, r, scr, lane);
                }
            }
        } }
    TE(2);
    SEAM(2);
    TB(3);
    if (IN(3)) REPS(3) { pg8::Gemm g{U, W2A, M, D, FF}; pg8::StaticOrder S; S.init(M, D, G, bx); pg8::EpiRes<false, true, true, 1> E{x, X1B, mod + 2 * D, H, args.in[9], mod + 4 * D, RSS + M};
        pg8::gemm_phase<pg8::EpiRes<false, true, true, 1>, pg8::StaticOrder, true, true>(lds, g, S, E);
        bias_rows(WIN, NIN, mod + 3 * D, BIAS2, gw, NGW, lane); bias_rows(W13B, 2 * FF, mod + 6 * D, BIAS3, gw, NGW, lane); }
    TE(3);
    SEAM(3);
    TB(5);
    if (IN(5)) REPS(5) { pg8::Gemm g{H, WIN, M, NIN, D}; pg8::StaticOrder S; S.init(M, NIN, G, bx);
        pg8::EpiIn E{ws, args.in[12], args.in[13], args.in[11], QSCALE, RSS + M, BIAS2};
        static_assert(pg8::EpiIn::oTAB == WS_TAB && pg8::EpiIn::oZ == WS_Z && pg8::EpiIn::oGR == WS_GR && pg8::EpiIn::oVR == WS_VR, "EpiIn workspace map");
        pg8::gemm_phase<pg8::EpiIn, pg8::StaticOrder, true, true>(lds, g, S, E); }
    TE(5);
    SEAM(5);
    TB(6);
    if (IN(6)) REPS(6) { for (int task = gw; task < 2048; task += NGW) ret_state_task(lds + wave * 8192, task, KR, VR, RT, args.in[19], args.in[20], lane); }
    TE(6);
    SEAM(6);
    TB(7);
    if (IN(7)) {
        const float l1 = wave_sum(args.in[14][lane] * args.in[15][lane]), l2 = wave_sum(args.in[16][lane] * args.in[17][lane]);
        const float lam = expf(l1) - expf(l2) + 0.2f;
        float mq = fabsf(args.in[12][lane]), mk = fabsf(args.in[13][lane]);
#pragma unroll
        for (int o = 1; o < 64; o <<= 1) { mq = fmaxf(mq, __shfl_xor(mq, o)); mk = fmaxf(mk, __shfl_xor(mk, o)); }
        const float negC = -(8.0f * LOG2E * mq * mk);
#ifndef NO_ATT
        _Pragma("unroll 1") for (int rep_ = 0; rep_ < (((DUPMASK >> 7) & 1) ? 2 : 1); ++rep_) for (int u = vcu; u < 512; u += G) attn_unit(lds, u >> 6, (u >> 4) & 3, u & 15, QA, KA, VA, OA, negC, lam, args.in[18]);
#endif
#ifndef NO_RET
        TB(14);
        for (int u = vcu; u < 512; u += G) { const int b = u >> 6, h = (u >> 4) & 3;
            const float lgf2 = -log1pf(expf(-args.in[19][h])) * LOG2E, lgb2 = -log1pf(expf(-args.in[20][h])) * LOG2E;
#ifdef RETDUP
            ret_unit(lds, b, h, u & 15, QR, KR, VR, RT, RG, args.in[21], lgf2, lgb2, args.ph_lo != 12345);
#endif
            ret_unit(lds, b, h, u & 15, QR, KR, VR, RT, RG, args.in[21], lgf2, lgb2, false); }
#endif
        TE(14);
    }
    TE(7);
    SEAM(7);
    TB(8);
    if (IN(8)) REPS(8) {
        { pg8::Gemm g{OA, WA, M, D, 512}; pg8::StaticOrder S; S.init(M, D, G, bx); pg8::EpiBr<0> E{T, GA}; pg8::gemm_phase<pg8::EpiBr<0>, pg8::StaticOrder, true, true>(lds, g, S, E); }
        { pg8::Gemm g{VR, WR, M, D, 512}; pg8::StaticOrder S; S.init(M, D, G, bx); pg8::EpiBr<1> E{T, GR}; pg8::gemm_phase<pg8::EpiBr<1>, pg8::StaticOrder, true, true>(lds, g, S, E); }
    }
    TE(8);
    SEAM(8);
    TB(9);
    if (IN(9)) { pg8::Gemm g{T, WO, M, D, D}; pg8::StaticOrder S; S.init(M, D, G, bx); pg8::EpiRes<true, true, true, 2> E{X1B, X2B, mod + 5 * D, H, args.in[25], mod + 7 * D, RSS + 2 * M};
        pg8::gemm_phase<pg8::EpiRes<true, true, true, 2>, pg8::StaticOrder, true, true>(lds, g, S, E); }
    TE(9);
    SEAM(9);
    TB(11);
    if (IN(11)) { pg8::Gemm g{H, W13B, M, 2 * FF, D}; pg8::StaticOrder S; S.init(M, 2 * FF, G, bx); pg8::EpiUp E{U, FF, RSS + 2 * M, BIAS3};
        pg8::gemm_phase<pg8::EpiUp, pg8::StaticOrder, true, true>(lds, g, S, E); }
    TE(11);
    SEAM(11);
    TB(12);
    if (IN(12)) { pg8::Gemm g{U, W2B, M, D, FF}; pg8::StaticOrder S; S.init(M, D, G, bx); pg8::EpiRes<true, false, false, 1> E{X2B, out, mod + 8 * D, nullptr, nullptr, nullptr, nullptr};
        pg8::gemm_phase<pg8::EpiRes<true, false, false, 1>, pg8::StaticOrder, true, true>(lds, g, S, E); }
    TE(12);
    if (TMASK && bx == 0 && tid == 0) { const unsigned long long t0_ = __builtin_amdgcn_s_memrealtime(); while (__builtin_amdgcn_s_memrealtime() - t0_ < 4ull * tacc_) __builtin_amdgcn_s_sleep(8); }
#undef IN
#undef SEAM
}

#undef x
#undef cvec
#undef positions
#undef w_ada
#undef b_ada
#undef out
#undef mod
#undef W13A
#undef W2A
#undef WIN
#undef WA
#undef WR
#undef WO
#undef W13B
#undef W2B
#undef cosA
#undef sinA
#undef cosR
#undef sinR
#undef H
#undef RT
#undef U
#undef QA
#undef KA
#undef VA
#undef QR
#undef KR
#undef VR
#undef RG
#undef GA
#undef GR
#undef T
#undef OA
#undef RSS
#undef X1B
#undef X2B
#undef BIAS1
#undef BIAS2
#undef BIAS3
extern "C" void kernel_launch(void* const* d_in, const int* in_sizes, int n_in, void* d_out, int out_size, void* d_ws, size_t ws_size, hipStream_t stream) {
    static int grid = 0;
    if (grid == 0) {
        if (n_in != 29 || out_size != M * D || ws_size < WS_END) { fprintf(stderr, "kernel_launch: unexpected shapes (n_in %d out %d ws %zu)\n", n_in, out_size, ws_size); grid = -1; return; }
        int dev = 0, cus = 0, per_cu = 0;
        (void)hipGetDevice(&dev); (void)hipDeviceGetAttribute(&cus, hipDeviceAttributeMultiprocessorCount, dev);
        if (hipFuncSetAttribute((const void*)mk_fwd, hipFuncAttributeMaxDynamicSharedMemorySize, LDS_BYTES) != hipSuccess) { fprintf(stderr, "kernel_launch: hipFuncSetAttribute failed\n"); grid = -1; return; }
        if (hipOccupancyMaxActiveBlocksPerMultiprocessor(&per_cu, (const void*)mk_fwd, NWAVES * 64, LDS_BYTES) != hipSuccess || per_cu < 1) { fprintf(stderr, "kernel_launch: occupancy query says %d\n", per_cu); per_cu = 1; }
        (void)hipGetLastError();
        grid = cus * 1;
        if (grid <= 0) grid = 256;
    }
    if (grid < 0) return;
    (void)hipMemsetAsync((char*)d_ws + WS_CTL, 0, CTL_ZERO_BYTES, stream);
    Args a{};
    for (int i = 0; i < 29; ++i) a.in[i] = (const float*)d_in[i];
    a.out = (float*)d_out; a.ws = (unsigned char*)d_ws;
#if MK_N_LAUNCHES == 1
    a.ph_lo = 0; a.ph_hi = N_PHASES + 1;
    void* kargs[] = {&a};
    hipError_t e = hipLaunchCooperativeKernel((const void*)mk_fwd, dim3(grid), dim3(NWAVES * 64), kargs, LDS_BYTES, stream);
    if (e != hipSuccess) fprintf(stderr, "kernel_launch: cooperative launch failed: %s (grid %d)\n", hipGetErrorString(e), grid);
#else
    for (int p = 0; p <= N_PHASES; ++p) { a.ph_lo = p; a.ph_hi = p + 1; hipLaunchKernelGGL(mk_fwd, dim3(grid), dim3(NWAVES * 64), LDS_BYTES, stream, a); }
#endif
}
```
